# Optimizing an MI355X kernel written in HIP

```python
import jax, jax.numpy as jnp
from jax import lax
import numpy as np

D_MODEL = 1024
BATCH = 4
SEQ = 4096
DEPTH = 1

CHUNK = 64
D_MIX = D_MODEL
D_CONV = D_MIX // 2
CONV_HEADS = 8
CONV_WIDTH = 3
D_POOL = D_MIX - D_CONV
POOL_WINDOWS = (2, 4, 8, 16)
POOL_GROUPS = len(POOL_WINDOWS)
POOL_GC = D_POOL // POOL_GROUPS
D_FF = 2816
EPS = 1e-6

kernel_name = "hybrid_conv_pool_macaron_block"


def rms_norm(x, g):
    xf = x.astype(jnp.float32)
    y = xf * lax.rsqrt(jnp.mean(xf * xf, axis=-1, keepdims=True) + EPS)
    return (y * g.astype(jnp.float32)).astype(x.dtype)


def swiglu(h, w_gate, w_up, w_down):
    return (jax.nn.silu(h @ w_gate) * (h @ w_up)) @ w_down


def causal_depthwise_conv(z, w):
    s = z.shape[1]
    zp = jnp.pad(z, ((0, 0), (CONV_WIDTH - 1, 0), (0, 0)))
    return sum(w[k] * zp[:, k:k + s] for k in range(CONV_WIDTH))


def multiscale_pool_minus_self(u):
    s = u.shape[1]
    uf = u.astype(jnp.float32)
    c = jnp.cumsum(uf, axis=1)
    t1 = jnp.arange(1, s + 1, dtype=jnp.float32)
    outs = []
    for g, w in enumerate(POOL_WINDOWS):
        cg = c[:, :, g]
        shifted = jnp.pad(cg, ((0, 0), (w, 0), (0, 0)))[:, :s]
        count = jnp.minimum(t1, float(w))[None, :, None]
        outs.append((cg - shifted) / count - uf[:, :, g])
    return jnp.stack(outs, axis=2).astype(u.dtype)


def setup_inputs(seed: int = 0) -> dict:
    key = jax.random.key(seed)
    ks = jax.random.split(key, 20)
    f32 = jnp.float32

    def nrm(k, shape, fan_in):
        return jax.random.normal(k, shape, f32) * (fan_in ** -0.5)

    def gain(k, shape):
        return 1.0 + 0.02 * jax.random.normal(k, shape, f32)

    L = DEPTH
    return {
        "x": jax.random.normal(ks[0], (BATCH, SEQ, D_MODEL), f32),
        "norm_ffn1": gain(ks[1], (L, D_MODEL)),
        "ffn1_w_gate": nrm(ks[2], (L, D_MODEL, D_FF), D_MODEL),
        "ffn1_w_up": nrm(ks[3], (L, D_MODEL, D_FF), D_MODEL),
        "ffn1_w_down": nrm(ks[4], (L, D_FF, D_MODEL), D_FF),
        "norm_mix": gain(ks[5], (L, D_MODEL)),
        "w_in": nrm(ks[6], (L, D_MODEL, 3 * D_CONV + D_POOL), D_MODEL),
        "conv_w": nrm(ks[7], (L, CONV_WIDTH, D_CONV), CONV_WIDTH),
        "pool_w": nrm(ks[8], (L, POOL_GROUPS, POOL_GC, POOL_GC), POOL_GC),
        "pool_scale": gain(ks[9], (L, D_POOL)),
        "w_out": nrm(ks[10], (L, D_MIX, D_MODEL), D_MIX),
        "norm_ffn2": gain(ks[11], (L, D_MODEL)),
        "ffn2_w_gate": nrm(ks[12], (L, D_MODEL, D_FF), D_MODEL),
        "ffn2_w_up": nrm(ks[13], (L, D_MODEL, D_FF), D_MODEL),
        "ffn2_w_down": nrm(ks[14], (L, D_FF, D_MODEL), D_FF),
        "norm_final": gain(ks[15], (D_MODEL,)),
    }


def reference(x, norm_ffn1, ffn1_w_gate, ffn1_w_up, ffn1_w_down, norm_mix, w_in, conv_w,
              pool_w, pool_scale, w_out, norm_ffn2, ffn2_w_gate, ffn2_w_up, ffn2_w_down,
              norm_final):
    b, s, _ = x.shape
    for l in range(DEPTH):
        x = x + 0.5 * swiglu(rms_norm(x, norm_ffn1[l]), ffn1_w_gate[l], ffn1_w_up[l], ffn1_w_down[l])

        h = rms_norm(x, norm_mix[l])
        proj = h @ w_in[l]
        v = proj[..., :D_CONV]
        gate_b = proj[..., D_CONV:2 * D_CONV]
        gate_c = proj[..., 2 * D_CONV:3 * D_CONV]
        u = proj[..., 3 * D_CONV:]

        y_a = gate_b * causal_depthwise_conv(gate_c * v, conv_w[l])

        ug = u.reshape(b, s, POOL_GROUPS, POOL_GC)
        pooled = multiscale_pool_minus_self(ug)
        y_b = jnp.einsum("bsgc,gcd->bsgd", pooled, pool_w[l]).reshape(b, s, D_POOL) * pool_scale[l]

        x = x + jnp.concatenate([y_a, y_b], axis=-1) @ w_out[l]

        x = x + 0.5 * swiglu(rms_norm(x, norm_ffn2[l]), ffn2_w_gate[l], ffn2_w_up[l], ffn2_w_down[l])
    return rms_norm(x, norm_final)
```

```cpp
#include <hip/hip_runtime.h>
#include <hip/hip_cooperative_groups.h>
#include <cstdio>
#include <cstdint>
namespace cg = cooperative_groups;
namespace pg8 {
#define PG8_LAS __attribute__((address_space(3)))
typedef unsigned short bf16_t;
typedef short bf16x8 __attribute__((ext_vector_type(8)));
typedef float f32x4 __attribute__((ext_vector_type(4)));
typedef unsigned u32x4 __attribute__((ext_vector_type(4)));
constexpr int BM = 256, BK = 64, HALF = 128, HTB = HALF * BK * 2  , STAGE_BYTES = 8 * HTB, NXCD = 8, WGM = 8;

__host__ __device__ __forceinline__ int lds_byte(int r, int c) { const int st = (r >> 4) * 2 + (c >> 5), rr = r & 15, cc = c & 31, ob = rr * 64 + cc * 2; return st * 1024 + (ob ^ (((ob >> 9) & 1) << 5)); }
__host__ __device__ __forceinline__ void stage_rc(int b, int& R, int& C) { const int st = b / 1024, sb = b % 1024, swz = sb ^ (((sb >> 9) & 1) << 5); R = (st >> 1) * 16 + swz / 64; C = (st & 1) * 32 + (swz % 64) / 2; }
__host__ __device__ __forceinline__ int perm32(int rho) { const int n = rho >> 4, i = rho & 15; return 8 * (i >> 2) + 4 * n + (i & 3); }

struct Unit { int pm, pn; };
struct Gemm { const bf16_t* A; const bf16_t* Bt; int M, N, K; };

struct StaticOrder {
    int nM, nN, nwg, G, c;
    __host__ __device__ void init(int M, int N, int G_, int c_) { nM = M / BM; nN = N / BM; nwg = nM * nN; G = G_; c = c_; }
    __host__ __device__ bool next(int i, Unit& u) const {
        const long L = (long)i * G + c; if (L >= nwg) return false;
        int wgid = (int)L; { const int q = nwg / NXCD, r = nwg % NXCD, xcd = wgid % NXCD, off = wgid / NXCD; wgid = (xcd < r ? xcd * (q + 1) : r * (q + 1) + (xcd - r) * q) + off; }
        const int nig = WGM * nN, gid = wgid / nig, fm = gid * WGM, gsz = (nM - fm) < WGM ? (nM - fm) : WGM;
        u.pm = fm + ((wgid % nig) % gsz); u.pn = (wgid % nig) / gsz; return true;
    }
    __device__ __forceinline__ void a_ready(const Unit&) const {}
    __device__ __forceinline__ void done(const Unit&) const {}
};

__device__ __forceinline__ unsigned cvt_pk_bf16(float lo, float hi) { unsigned r; asm volatile("v_cvt_pk_bf16_f32 %0, %1, %2" : "=v"(r) : "v"(lo), "v"(hi)); return r; }
typedef float f32x2 __attribute__((ext_vector_type(2)));
constexpr float RMS_EPS = 1e-6f, INV_D = 1.0f / 1024.0f;
__device__ __forceinline__ float rms_rstd(const float* ssq, int row) { return 1.0f / sqrtf(ssq[row] * INV_D + RMS_EPS); }
__device__ __forceinline__ float silu_f(float x) { return x * __builtin_amdgcn_rcpf(1.0f + __builtin_amdgcn_exp2f(x * -1.44269504089f)); }

template <bool ROWS, bool COLS> struct EpiScaleBf16 {
    static constexpr bool PERM = true, AFTER_DRAIN = false;
    bf16_t* O; int ldc; int coff; const float* ssq; const float* cs;
    __device__ __forceinline__ void operator()(const f32x4 (&acc)[2][2][4][2], const Unit& u, int wr, int wc, int fr, int fq) const {
        const int row0 = u.pm * BM + wr * 64 + fr, col0 = u.pn * BM + wc * 32 + 8 * fq;
        f32x4 cv[2][2];
#pragma unroll
        for (int bj = 0; bj < 2; ++bj)
#pragma unroll
            for (int n = 0; n < 2; ++n) cv[bj][n] = COLS ? *(const f32x4*)(cs + col0 + bj * HALF + 4 * n) : (f32x4){1.f, 1.f, 1.f, 1.f};
#pragma unroll
        for (int ai = 0; ai < 2; ++ai)
#pragma unroll
            for (int m = 0; m < 4; ++m) { const int row = row0 + ai * HALF + m * 16; const float r = ROWS ? rms_rstd(ssq, row) : 1.f;
                bf16_t* rowp = O + (size_t)row * ldc + coff + col0;
#pragma unroll
                for (int bj = 0; bj < 2; ++bj) { f32x4 v0 = acc[ai][bj][m][0] * r, v1 = acc[ai][bj][m][1] * r;
                    if (COLS) { v0 = v0 * cv[bj][0]; v1 = v1 * cv[bj][1]; }
                    u32x4 w; w.x = cvt_pk_bf16(v0[0], v0[1]); w.y = cvt_pk_bf16(v0[2], v0[3]); w.z = cvt_pk_bf16(v1[0], v1[1]); w.w = cvt_pk_bf16(v1[2], v1[3]);
                    *(u32x4*)(rowp + bj * HALF) = w; } }
    }
};
struct EpiSwiglu {
    static constexpr bool PERM = true, AFTER_DRAIN = false;
    bf16_t* O; int ldc; const float* ssq;
    __device__ __forceinline__ void operator()(const f32x4 (&acc)[2][2][4][2], const Unit& u, int wr, int wc, int fr, int fq) const {
        const int row0 = u.pm * BM + wr * 64 + fr, col0 = u.pn * HALF + wc * 32 + 8 * fq;
#pragma unroll
        for (int ai = 0; ai < 2; ++ai)
#pragma unroll
            for (int m = 0; m < 4; ++m) { const int row = row0 + ai * HALF + m * 16; const float r = rms_rstd(ssq, row);
                const f32x4 g0 = acc[ai][0][m][0] * r, g1 = acc[ai][0][m][1] * r, u0 = acc[ai][1][m][0] * r, u1 = acc[ai][1][m][1] * r;
                f32x4 a0, a1;
#pragma unroll
                for (int e = 0; e < 4; ++e) { a0[e] = silu_f(g0[e]) * u0[e]; a1[e] = silu_f(g1[e]) * u1[e]; }
                u32x4 w; w.x = cvt_pk_bf16(a0[0], a0[1]); w.y = cvt_pk_bf16(a0[2], a0[3]); w.z = cvt_pk_bf16(a1[0], a1[1]); w.w = cvt_pk_bf16(a1[2], a1[3]);
                *(u32x4*)(O + (size_t)row * ldc + col0) = w; }
    }
};
template <bool WRITE_XB> struct EpiResid {
    static constexpr bool PERM = true, AFTER_DRAIN = false;
    const float* res; float* out; bf16_t* xb; float* ssq; float alpha;
    __device__ __forceinline__ void operator()(const f32x4 (&acc)[2][2][4][2], const Unit& u, int wr, int wc, int fr, int fq) const {
        const int row0 = u.pm * BM + wr * 64 + fr, col0 = u.pn * BM + wc * 32 + 8 * fq;
#pragma unroll
        for (int ai = 0; ai < 2; ++ai)
#pragma unroll
            for (int m = 0; m < 4; ++m) { const int row = row0 + ai * HALF + m * 16; const size_t off = (size_t)row * 1024 + col0; float s = 0.f;
#pragma unroll
                for (int bj = 0; bj < 2; ++bj) {
                    const f32x4 r0 = *(const f32x4*)(res + off + bj * HALF), r1 = *(const f32x4*)(res + off + bj * HALF + 4);
                    const f32x4 o0 = r0 + acc[ai][bj][m][0] * alpha, o1 = r1 + acc[ai][bj][m][1] * alpha;
                    *(f32x4*)(out + off + bj * HALF) = o0; *(f32x4*)(out + off + bj * HALF + 4) = o1;
                    s += (o0[0] * o0[0] + o0[1] * o0[1]) + (o0[2] * o0[2] + o0[3] * o0[3]) + (o1[0] * o1[0] + o1[1] * o1[1]) + (o1[2] * o1[2] + o1[3] * o1[3]);
                    if (WRITE_XB) { u32x4 w; w.x = cvt_pk_bf16(o0[0], o0[1]); w.y = cvt_pk_bf16(o0[2], o0[3]); w.z = cvt_pk_bf16(o1[0], o1[1]); w.w = cvt_pk_bf16(o1[2], o1[3]);
                        *(u32x4*)(xb + off + bj * HALF) = w; } }
                s += __shfl_xor(s, 16); s += __shfl_xor(s, 32);
                if (fq == 0) (void)__hip_atomic_fetch_add(ssq + row, s, __ATOMIC_RELAXED, __HIP_MEMORY_SCOPE_AGENT);
                asm volatile("" ::: "memory"); }
    }
};

template <class Epi, class Sched, bool ALIGN_EPI = false, bool SP2 = false>
__device__ __forceinline__ void gemm_phase(PG8_LAS unsigned char* lds, const Gemm g, const Sched& S, const Epi& E) {
    const int tid = threadIdx.x, wid = __builtin_amdgcn_readfirstlane(tid >> 6), lane = tid & 63, wr = wid >> 2, wc = wid & 3, fr = lane & 15, fq = lane >> 4;
    const int K = g.K, nt = K / BK;
    unsigned voffA[2], voffB[2];
#pragma unroll
    for (int i = 0; i < 2; ++i) { int R, C; stage_rc(tid * 16 + i * 8192, R, C); const int Rb = Epi::PERM ? ((R & ~31) + perm32(R & 31)) : R;
        voffA[i] = (unsigned)(R * K + C) * 2u; voffB[i] = (unsigned)(Rb * K + C) * 2u; }
    const size_t kstep = (size_t)(BK * 2);
    const size_t hstep = (size_t)HALF * K * 2;
    const size_t tstep = 2 * hstep;
    const unsigned ldsw = (unsigned)wid * 1024u;
    const int aoff = lds_byte(wr * 64 + fr, fq * 8), boff = lds_byte(wc * 32 + fr, fq * 8);
#define PG8_SA(b, h) (((b) * 2 + (h)) * HTB)
#define PG8_SB(b, h) ((4 + (b) * 2 + (h)) * HTB)
#define PG8_STAGE(bufoff, gbase, voff) do { _Pragma("unroll") for (int _i = 0; _i < 2; ++_i) \
        __builtin_amdgcn_global_load_lds((const unsigned*)((const char*)(gbase) + (voff)[_i]), (PG8_LAS unsigned*)(lds + (bufoff) + ldsw + _i * 8192), 16, 0, 0); } while (0)
#define PG8_LDA(dst, b, h) do { _Pragma("unroll") for (int m = 0; m < 4; ++m) _Pragma("unroll") for (int k = 0; k < 2; ++k) dst[m][k] = *(const PG8_LAS bf16x8*)(lds + PG8_SA(b, h) + aoff + m * 2048 + k * 1024); } while (0)
#define PG8_LDB(dst, b, h) do { _Pragma("unroll") for (int n = 0; n < 2; ++n) _Pragma("unroll") for (int k = 0; k < 2; ++k) dst[n][k] = *(const PG8_LAS bf16x8*)(lds + PG8_SB(b, h) + boff + n * 2048 + k * 1024); } while (0)
#define PG8_MMA(ai, bj, At, Bt) do { __builtin_amdgcn_s_setprio(1); _Pragma("unroll") for (int m = 0; m < 4; ++m) _Pragma("unroll") for (int n = 0; n < 2; ++n) _Pragma("unroll") for (int k = 0; k < 2; ++k) \
        acc[ai][bj][m][n] = __builtin_amdgcn_mfma_f32_16x16x32_bf16(Bt[n][k], At[m][k], acc[ai][bj][m][n], 0, 0, 0); __builtin_amdgcn_s_setprio(0); } while (0)
#define PG8_WAIT_V(n) asm volatile("s_waitcnt vmcnt(" #n ")" ::: "memory")
#define PG8_WAIT_L(n) asm volatile("s_waitcnt lgkmcnt(" #n ")" ::: "memory")
#define PG8_BAR __builtin_amdgcn_s_barrier()
#define PG8_SCHED __builtin_amdgcn_sched_barrier(0)
    Unit cur, nxt; int ui = 0;
    if (!S.next(0, cur)) return;
    f32x4 acc[2][2][4][2];
#pragma unroll
    for (int a = 0; a < 2; ++a)
#pragma unroll
        for (int b = 0; b < 2; ++b)
#pragma unroll
            for (int m = 0; m < 4; ++m)
#pragma unroll
                for (int n = 0; n < 2; ++n) acc[a][b][m][n] = (f32x4){0.f, 0.f, 0.f, 0.f};
    bf16x8 At[4][2], B0[2][2], B1[2][2];
    const char* cA = (const char*)g.A + (size_t)cur.pm * tstep; const char* cB = (const char*)g.Bt + (size_t)cur.pn * tstep;
    S.a_ready(cur);
    if constexpr (SP2) {
        PG8_STAGE(PG8_SB(0, 0), cB, voffB); PG8_STAGE(PG8_SB(0, 1), cB + hstep, voffB); PG8_STAGE(PG8_SA(0, 0), cA, voffA); PG8_STAGE(PG8_SA(0, 1), cA + hstep, voffA);
        if (wr == 1) PG8_BAR;
        PG8_WAIT_V(2); PG8_BAR;
        PG8_STAGE(PG8_SB(1, 0), cB + kstep, voffB); PG8_STAGE(PG8_SA(1, 0), cA + kstep, voffA); PG8_STAGE(PG8_SB(1, 1), cB + hstep + kstep, voffB);
        PG8_WAIT_V(6); PG8_BAR;
    } else {
        PG8_STAGE(PG8_SB(0, 0), cB, voffB); PG8_STAGE(PG8_SA(0, 0), cA, voffA); PG8_STAGE(PG8_SB(0, 1), cB + hstep, voffB); PG8_STAGE(PG8_SA(0, 1), cA + hstep, voffA);
        if (wr == 1) PG8_BAR;
        PG8_WAIT_V(4); PG8_BAR;
        PG8_STAGE(PG8_SB(1, 0), cB + kstep, voffB); PG8_STAGE(PG8_SA(1, 0), cA + kstep, voffA); PG8_STAGE(PG8_SB(1, 1), cB + hstep + kstep, voffB);
        PG8_WAIT_V(6); PG8_BAR;
    }
    for (;;) {
        const bool has_next = S.next(ui + 1, nxt);
        const char* nA = has_next ? (const char*)g.A + (size_t)nxt.pm * tstep : cA; const char* nB = has_next ? (const char*)g.Bt + (size_t)nxt.pn * tstep : cB;
        for (int t = 0; t < nt; t += 2) {
            const bool last = (t == nt - 2);
            const char* a1 = cA + (size_t)(t + 1) * kstep;
            const char* a2 = last ? nA : cA + (size_t)(t + 2) * kstep; const char* b2 = last ? nB : cB + (size_t)(t + 2) * kstep;
            const char* a3 = a2 + kstep; const char* b3 = b2 + kstep;
            if (last && has_next) S.a_ready(nxt);
            if constexpr (SP2) {
            PG8_LDB(B0, 0, 0); PG8_LDB(B1, 0, 1); PG8_SCHED; PG8_LDA(At, 0, 0); PG8_STAGE(PG8_SA(1, 1), a1 + hstep, voffA);
            PG8_WAIT_V(8); PG8_WAIT_L(0); PG8_BAR; PG8_MMA(0, 0, At, B0); PG8_MMA(0, 1, At, B1); PG8_BAR; PG8_SCHED;
            PG8_LDA(At, 0, 1); PG8_STAGE(PG8_SB(0, 0), b2, voffB); PG8_STAGE(PG8_SB(0, 1), b2 + hstep, voffB); PG8_STAGE(PG8_SA(0, 0), a2, voffA);
            PG8_WAIT_V(8); PG8_WAIT_L(0); PG8_BAR; PG8_MMA(1, 0, At, B0); PG8_MMA(1, 1, At, B1); PG8_BAR; PG8_SCHED;
            PG8_LDB(B0, 1, 0); PG8_LDB(B1, 1, 1); PG8_SCHED; PG8_LDA(At, 1, 0); PG8_STAGE(PG8_SA(0, 1), a2 + hstep, voffA);
            PG8_WAIT_V(8); PG8_WAIT_L(0); PG8_BAR; PG8_MMA(0, 0, At, B0); PG8_MMA(0, 1, At, B1); PG8_BAR; PG8_SCHED;
            PG8_LDA(At, 1, 1); PG8_STAGE(PG8_SB(1, 0), b3, voffB); PG8_STAGE(PG8_SB(1, 1), b3 + hstep, voffB); PG8_STAGE(PG8_SA(1, 0), a3, voffA);
            PG8_WAIT_V(8); PG8_WAIT_L(0); PG8_BAR; PG8_MMA(1, 0, At, B0); PG8_MMA(1, 1, At, B1); PG8_BAR; PG8_SCHED;
            } else {
            PG8_LDB(B0, 0, 0); PG8_SCHED; PG8_LDA(At, 0, 0); PG8_STAGE(PG8_SA(1, 1), a1 + hstep, voffA);
            PG8_WAIT_L(8); PG8_BAR; PG8_WAIT_L(0); PG8_MMA(0, 0, At, B0); PG8_BAR; PG8_SCHED;
            PG8_LDB(B1, 0, 1); PG8_STAGE(PG8_SB(0, 0), b2, voffB);
            PG8_BAR; PG8_WAIT_L(0); PG8_MMA(0, 1, At, B1); PG8_BAR;
            PG8_LDA(At, 0, 1); PG8_STAGE(PG8_SA(0, 0), a2, voffA);
            PG8_BAR; PG8_WAIT_L(0); PG8_MMA(1, 0, At, B0); PG8_BAR; PG8_SCHED;
            PG8_STAGE(PG8_SB(0, 1), b2 + hstep, voffB);
            PG8_WAIT_V(6); PG8_BAR; PG8_MMA(1, 1, At, B1); PG8_BAR;
            PG8_LDB(B0, 1, 0); PG8_SCHED; PG8_LDA(At, 1, 0); PG8_STAGE(PG8_SA(0, 1), a2 + hstep, voffA);
            PG8_WAIT_L(8); PG8_BAR; PG8_WAIT_L(0); PG8_MMA(0, 0, At, B0); PG8_BAR; PG8_SCHED;
            PG8_LDB(B1, 1, 1); PG8_STAGE(PG8_SB(1, 0), b3, voffB);
            PG8_BAR; PG8_WAIT_L(0); PG8_MMA(0, 1, At, B1); PG8_BAR;
            PG8_LDA(At, 1, 1); PG8_STAGE(PG8_SA(1, 0), a3, voffA);
            PG8_BAR; PG8_WAIT_L(0); PG8_MMA(1, 0, At, B0); PG8_BAR; PG8_SCHED;
            PG8_STAGE(PG8_SB(1, 1), b3 + hstep, voffB);
            PG8_WAIT_V(6); PG8_BAR; PG8_MMA(1, 1, At, B1); PG8_BAR;
            }
        }
        if constexpr (ALIGN_EPI) { if (wr == 0) PG8_BAR; }
        if constexpr (!Epi::AFTER_DRAIN) { E(acc, cur, wr, wc, fr, fq); S.done(cur); }
        if (!has_next) break;
#pragma unroll
        for (int a = 0; a < 2; ++a)
#pragma unroll
            for (int b = 0; b < 2; ++b)
#pragma unroll
                for (int m = 0; m < 4; ++m)
#pragma unroll
                    for (int n = 0; n < 2; ++n) acc[a][b][m][n] = (f32x4){0.f, 0.f, 0.f, 0.f};
        cur = nxt; cA = nA; cB = nB; ++ui;
        if constexpr (ALIGN_EPI) { if (wr == 1) PG8_BAR; }
    }
    PG8_WAIT_V(0);
    if constexpr (!ALIGN_EPI) { if (wr == 0) PG8_BAR; }
    PG8_BAR;
    if constexpr (Epi::AFTER_DRAIN) { E.fused(acc, cur, wr, wc, fr, fq, lds, wid, lane); S.done(cur); }
#undef PG8_SA
#undef PG8_SB
#undef PG8_STAGE
#undef PG8_LDA
#undef PG8_LDB
#undef PG8_MMA
#undef PG8_WAIT_V
#undef PG8_WAIT_L
#undef PG8_BAR
#undef PG8_SCHED
}
}

#ifndef MK_N_LAUNCHES
#define MK_N_LAUNCHES 1
#endif
constexpr int NWAVES = 8;
constexpr int BATCH = 4, SEQ = 4096, D = 1024, FF = 2816, DCONV = 512, DPOOL = 512, NPROJ = 2048;
constexpr int M = BATCH * SEQ;
constexpr int N_PHASES = 10;
constexpr size_t MiB = 1u << 20;
constexpr size_t WS_SSQ = 0;
constexpr size_t WS_WGU1 = 2 * MiB, WS_WD1 = 13 * MiB, WS_WIN = 19 * MiB, WS_WPOOL = 23 * MiB, WS_WOUT = 24 * MiB, WS_WGU2 = 26 * MiB, WS_WD2 = 37 * MiB;
constexpr size_t WS_XB = 44 * MiB;
constexpr size_t WS_H = 76 * MiB;
constexpr size_t WS_PROJ = 76 * MiB, WS_POOLED = 140 * MiB;
constexpr size_t WS_YC = 164 * MiB, WS_END = 196 * MiB;
static_assert(WS_WGU1 + (size_t)2 * FF * D * 2 <= WS_WD1 && WS_WD1 + (size_t)D * FF * 2 <= WS_WIN && WS_WGU2 + (size_t)2 * FF * D * 2 <= WS_WD2 && WS_WD2 + (size_t)D * FF * 2 <= WS_XB, "ws map");
static_assert(WS_H + (size_t)M * FF * 2 <= WS_YC && WS_POOLED + (size_t)M * DPOOL * 2 <= WS_YC && WS_PROJ + (size_t)M * NPROJ * 2 <= WS_POOLED, "ws map");
constexpr int LDS_BYTES = 147456;

#define GAS __attribute__((address_space(1)))
#define LAS __attribute__((address_space(3)))
typedef unsigned short bf16;
typedef unsigned v4u __attribute__((ext_vector_type(4)));
typedef unsigned v2u __attribute__((ext_vector_type(2)));
typedef float f32x4 __attribute__((ext_vector_type(4)));
#define LDS_WAIT() asm volatile("s_waitcnt lgkmcnt(0)" ::: "memory")
using pg8::cvt_pk_bf16;

struct Frame {
    LAS unsigned char* lds;
    int tid, lane, wave, vcu, G;
    const float *x, *g1, *wg1, *wu1, *wd1, *gmix, *win, *convw, *poolw, *pscale, *wout, *g2, *wg2, *wu2, *wd2, *gfin;
    float* out; float *ssq0, *ssq1, *ssq2, *ssq3;
    bf16 *WGU1, *WD1, *WIN, *WPOOL, *WOUT, *WGU2, *WD2, *XB, *H, *PROJ, *POOLED, *YC;
};

__device__ __forceinline__ float wave_sum(float v) {
#pragma unroll
    for (int o = 1; o < 64; o <<= 1) v += __shfl_xor(v, o);
    return v;
}
__device__ __forceinline__ void p0_transpose_item(const float* W, int K, int N, bf16* WT, int mode, const float* gk, LAS float* scr, int item, int lane) {
    const int nblk = N / 32, kb = item / nblk, nb = item % nblk, k0 = 64 * kb, n0 = 32 * nb;
#pragma unroll 8
    for (int i = 0; i < 32; ++i) { const int kk = 2 * i + (lane >> 5); const float s = gk ? gk[k0 + kk] : 1.f; scr[kk * 33 + (lane & 31)] = W[(size_t)(k0 + kk) * N + n0 + (lane & 31)] * s; }
    LDS_WAIT(); asm volatile("" ::: "memory");
    const int c = lane & 7;
    const int d0 = (mode == 0) ? n0 : ((n0 >> 7) * 256 + (n0 & 127) + (mode == 2 ? 128 : 0));
#pragma unroll
    for (int j = 0; j < 4; ++j) { const int n = (lane >> 3) + 8 * j; const LAS float* s = scr + (8 * c) * 33 + n;
        v4u o; o.x = cvt_pk_bf16(s[0 * 33], s[1 * 33]); o.y = cvt_pk_bf16(s[2 * 33], s[3 * 33]); o.z = cvt_pk_bf16(s[4 * 33], s[5 * 33]); o.w = cvt_pk_bf16(s[6 * 33], s[7 * 33]);
        *(GAS v4u*)(WT + (size_t)(d0 + n) * K + k0 + 8 * c) = o; }
    LDS_WAIT(); asm volatile("" ::: "memory");
}
__device__ __forceinline__ void p0_prologue(Frame& F) {
    LAS float* scr = (LAS float*)(F.lds + F.wave * 16384);
    const int gw = F.vcu * NWAVES + F.wave, NGW = F.G * NWAVES;
    constexpr int I_GU = (D / 64) * (FF / 32), I_DN = (FF / 64) * (D / 32), I_IN = (D / 64) * (NPROJ / 32), I_OUT = (D / 64) * (D / 32);
    constexpr int NITEMS = 4 * I_GU + 2 * I_DN + I_IN + I_OUT;
    for (int it = gw; it < NITEMS; it += NGW) {
        int r = it;
        if (r < I_GU) { p0_transpose_item(F.wg1, D, FF, F.WGU1, 1, F.g1, scr, r, F.lane); continue; } r -= I_GU;
        if (r < I_GU) { p0_transpose_item(F.wu1, D, FF, F.WGU1, 2, F.g1, scr, r, F.lane); continue; } r -= I_GU;
        if (r < I_GU) { p0_transpose_item(F.wg2, D, FF, F.WGU2, 1, F.g2, scr, r, F.lane); continue; } r -= I_GU;
        if (r < I_GU) { p0_transpose_item(F.wu2, D, FF, F.WGU2, 2, F.g2, scr, r, F.lane); continue; } r -= I_GU;
        if (r < I_DN) { p0_transpose_item(F.wd1, FF, D, F.WD1, 0, nullptr, scr, r, F.lane); continue; } r -= I_DN;
        if (r < I_DN) { p0_transpose_item(F.wd2, FF, D, F.WD2, 0, nullptr, scr, r, F.lane); continue; } r -= I_DN;
        if (r < I_IN) { p0_transpose_item(F.win, D, NPROJ, F.WIN, 0, F.gmix, scr, r, F.lane); continue; } r -= I_IN;
        p0_transpose_item(F.wout, D, D, F.WOUT, 0, nullptr, scr, r, F.lane);
    }
    const int gt = F.vcu * (NWAVES * 64) + F.tid, NGT = F.G * NWAVES * 64;
    for (int idx = gt; idx < DPOOL * DPOOL; idx += NGT) { const int n = idx >> 9, k = idx & 511; const int gn = n >> 7, gk = k >> 7;
        const float v = (gn == gk) ? F.poolw[(size_t)gn * 16384 + (k & 127) * 128 + (n & 127)] : 0.f;
        F.WPOOL[idx] = (bf16)(cvt_pk_bf16(v, 0.f) & 0xffffu); }
    for (int idx = gt; idx < 3 * M; idx += NGT) F.ssq1[idx] = 0.f;
    for (int m = gw; m < M; m += NGW) {
        const GAS f32x4* xr = (const GAS f32x4*)(F.x + (size_t)m * D) + F.lane;
        f32x4 v[4]; float s = 0.f;
#pragma unroll
        for (int j = 0; j < 4; ++j) { v[j] = xr[64 * j]; s += (v[j].x * v[j].x + v[j].y * v[j].y) + (v[j].z * v[j].z + v[j].w * v[j].w); }
        s = wave_sum(s);
        if (F.lane == 0) F.ssq0[m] = s;
        GAS v2u* o8 = (GAS v2u*)(F.XB + (size_t)m * D) + F.lane;
#pragma unroll
        for (int j = 0; j < 4; ++j) { v2u o; o.x = cvt_pk_bf16(v[j].x, v[j].y); o.y = cvt_pk_bf16(v[j].z, v[j].w); o8[64 * j] = o; }
    }
}
__device__ __forceinline__ void unpack8(const v4u q, float (&f)[8]) {
    f[0] = __uint_as_float(q.x << 16); f[1] = __uint_as_float(q.x & 0xffff0000u); f[2] = __uint_as_float(q.y << 16); f[3] = __uint_as_float(q.y & 0xffff0000u);
    f[4] = __uint_as_float(q.z << 16); f[5] = __uint_as_float(q.z & 0xffff0000u); f[6] = __uint_as_float(q.w << 16); f[7] = __uint_as_float(q.w & 0xffff0000u);
}
__device__ __forceinline__ v4u pack8(const float (&f)[8]) { v4u o; o.x = cvt_pk_bf16(f[0], f[1]); o.y = cvt_pk_bf16(f[2], f[3]); o.z = cvt_pk_bf16(f[4], f[5]); o.w = cvt_pk_bf16(f[6], f[7]); return o; }
__device__ __forceinline__ void mix_phase(Frame& F) {
    const int lane = F.lane, c8 = lane * 8, w = 2 << (lane >> 4);
    float w0[8], w1[8], w2[8];
#pragma unroll
    for (int e = 0; e < 8; ++e) { w0[e] = F.convw[c8 + e]; w1[e] = F.convw[DCONV + c8 + e]; w2[e] = F.convw[2 * DCONV + c8 + e]; }
    const int gw = F.vcu * NWAVES + F.wave, NGW = F.G * NWAVES;
    for (int item = gw; item < M / 8; item += NGW) {
        const int t0 = item * 8, p0 = t0 & (SEQ - 1);
        const bf16* prow = F.PROJ + (size_t)t0 * NPROJ + c8;
        float z1[8], z2[8];
#pragma unroll
        for (int e = 0; e < 8; ++e) { z1[e] = 0.f; z2[e] = 0.f; }
        if (p0 > 0) { float a[8], b[8];
            unpack8(*(const GAS v4u*)(prow - 2 * NPROJ), a); unpack8(*(const GAS v4u*)(prow - 2 * NPROJ + 1024), b);
#pragma unroll
            for (int e = 0; e < 8; ++e) z2[e] = a[e] * b[e];
            unpack8(*(const GAS v4u*)(prow - NPROJ), a); unpack8(*(const GAS v4u*)(prow - NPROJ + 1024), b);
#pragma unroll
            for (int e = 0; e < 8; ++e) z1[e] = a[e] * b[e]; }
#pragma unroll
        for (int j = 0; j < 8; ++j) { float a[8], b[8], c[8], y[8];
            unpack8(*(const GAS v4u*)(prow + j * NPROJ), a); unpack8(*(const GAS v4u*)(prow + j * NPROJ + 512), b); unpack8(*(const GAS v4u*)(prow + j * NPROJ + 1024), c);
#pragma unroll
            for (int e = 0; e < 8; ++e) { const float z0 = c[e] * a[e]; y[e] = b[e] * (w0[e] * z2[e] + w1[e] * z1[e] + w2[e] * z0); z2[e] = z1[e]; z1[e] = z0; }
            *(GAS v4u*)(F.YC + (size_t)(t0 + j) * D + c8) = pack8(y); }
        const bf16* urow = prow + 1536;
        float S[8];
#pragma unroll
        for (int e = 0; e < 8; ++e) S[e] = 0.f;
#pragma unroll
        for (int i = 15; i >= 1; --i) if (i < w && p0 - i >= 0) { float a[8]; unpack8(*(const GAS v4u*)(urow - i * NPROJ), a);
#pragma unroll
            for (int e = 0; e < 8; ++e) S[e] += a[e]; }
#pragma unroll
        for (int j = 0; j < 8; ++j) { float a[8], y[8]; unpack8(*(const GAS v4u*)(urow + j * NPROJ), a);
            const int cnt = (p0 + j + 1) < w ? (p0 + j + 1) : w; const float inv = 1.0f / (float)cnt;
#pragma unroll
            for (int e = 0; e < 8; ++e) { S[e] += a[e]; y[e] = S[e] * inv - a[e]; }
            *(GAS v4u*)(F.POOLED + (size_t)(t0 + j) * DPOOL + c8) = pack8(y);
            const int idx = j - (w - 1);
            if (p0 + idx >= 0) { float o[8]; unpack8(*(const GAS v4u*)(urow + idx * NPROJ), o);
#pragma unroll
                for (int e = 0; e < 8; ++e) S[e] -= o[e]; } }
    }
}
__device__ __forceinline__ void final_norm(Frame& F) {
    const int gw = F.vcu * NWAVES + F.wave, NGW = F.G * NWAVES;
    f32x4 gf[4];
#pragma unroll
    for (int j = 0; j < 4; ++j) gf[j] = ((const GAS f32x4*)F.gfin)[64 * j + F.lane];
    for (int m = gw; m < M; m += NGW) { const float r = pg8::rms_rstd(F.ssq3, m);
        GAS f32x4* xr = (GAS f32x4*)(F.out + (size_t)m * D) + F.lane;
#pragma unroll
        for (int j = 0; j < 4; ++j) { const f32x4 v = xr[64 * j]; xr[64 * j] = v * r * gf[j]; } }
}

struct Args { const float* in[16]; float* out; unsigned char* ws; int ph_lo, ph_hi; };
__global__ void __launch_bounds__(NWAVES * 64, 2) fwd_kernel(Args args) {
    extern __shared__ __attribute__((aligned(16))) unsigned char lds[];
    cg::grid_group grid = cg::this_grid();
    Frame F;
    F.lds = (LAS unsigned char*)lds;
    F.tid = threadIdx.x; F.lane = F.tid & 63; F.wave = __builtin_amdgcn_readfirstlane(F.tid >> 6);
    F.G = gridDim.x; { const int bx = blockIdx.x; F.vcu = (F.G % 8 == 0) ? (bx % 8) * (F.G / 8) + bx / 8 : bx; }
    unsigned char* ws = args.ws;
    F.x = args.in[0]; F.g1 = args.in[1]; F.wg1 = args.in[2]; F.wu1 = args.in[3]; F.wd1 = args.in[4]; F.gmix = args.in[5]; F.win = args.in[6]; F.convw = args.in[7];
    F.poolw = args.in[8]; F.pscale = args.in[9]; F.wout = args.in[10]; F.g2 = args.in[11]; F.wg2 = args.in[12]; F.wu2 = args.in[13]; F.wd2 = args.in[14]; F.gfin = args.in[15];
    F.out = args.out;
    F.ssq0 = (float*)(ws + WS_SSQ); F.ssq1 = F.ssq0 + M; F.ssq2 = F.ssq1 + M; F.ssq3 = F.ssq2 + M;
    F.WGU1 = (bf16*)(ws + WS_WGU1); F.WD1 = (bf16*)(ws + WS_WD1); F.WIN = (bf16*)(ws + WS_WIN); F.WPOOL = (bf16*)(ws + WS_WPOOL); F.WOUT = (bf16*)(ws + WS_WOUT);
    F.WGU2 = (bf16*)(ws + WS_WGU2); F.WD2 = (bf16*)(ws + WS_WD2); F.XB = (bf16*)(ws + WS_XB); F.H = (bf16*)(ws + WS_H); F.PROJ = (bf16*)(ws + WS_PROJ);
    F.POOLED = (bf16*)(ws + WS_POOLED); F.YC = (bf16*)(ws + WS_YC);
    const int lo = args.ph_lo, hi = args.ph_hi;
#define IN(k) (lo <= (k) && (k) < hi)
#define SEAM(k) do { if (IN(k) && IN((k) + 1)) grid.sync(); } while (0)
    const int bx = (int)blockIdx.x;
    if (IN(0)) { p0_prologue(F); } SEAM(0);
    if (IN(1)) { pg8::Gemm g{F.XB, F.WGU1, M, 2 * FF, D}; pg8::StaticOrder S; S.init(M, 2 * FF, F.G, bx);
        pg8::EpiSwiglu E{F.H, FF, F.ssq0};
        pg8::gemm_phase<pg8::EpiSwiglu, pg8::StaticOrder, true, true>(F.lds, g, S, E); } SEAM(1);
    if (IN(2)) { pg8::Gemm g{F.H, F.WD1, M, D, FF}; pg8::StaticOrder S; S.init(M, D, F.G, bx);
        pg8::EpiResid<true> E{F.x, F.out, F.XB, F.ssq1, 0.5f};
        pg8::gemm_phase<pg8::EpiResid<true>, pg8::StaticOrder, true, true>(F.lds, g, S, E); } SEAM(2);
    if (IN(3)) { pg8::Gemm g{F.XB, F.WIN, M, NPROJ, D}; pg8::StaticOrder S; S.init(M, NPROJ, F.G, bx);
        pg8::EpiScaleBf16<true, false> E{F.PROJ, NPROJ, 0, F.ssq1, nullptr};
        pg8::gemm_phase<pg8::EpiScaleBf16<true, false>, pg8::StaticOrder, true, true>(F.lds, g, S, E); } SEAM(3);
    if (IN(4)) { mix_phase(F); } SEAM(4);
    if (IN(5)) { pg8::Gemm g{F.POOLED, F.WPOOL, M, DPOOL, DPOOL}; pg8::StaticOrder S; S.init(M, DPOOL, F.G, bx);
        pg8::EpiScaleBf16<false, true> E{F.YC, D, DCONV, nullptr, F.pscale};
        pg8::gemm_phase<pg8::EpiScaleBf16<false, true>, pg8::StaticOrder, true, true>(F.lds, g, S, E); } SEAM(5);
    if (IN(6)) { pg8::Gemm g{F.YC, F.WOUT, M, D, D}; pg8::StaticOrder S; S.init(M, D, F.G, bx);
        pg8::EpiResid<true> E{F.out, F.out, F.XB, F.ssq2, 1.0f};
        pg8::gemm_phase<pg8::EpiResid<true>, pg8::StaticOrder, true, true>(F.lds, g, S, E); } SEAM(6);
    if (IN(7)) { pg8::Gemm g{F.XB, F.WGU2, M, 2 * FF, D}; pg8::StaticOrder S; S.init(M, 2 * FF, F.G, bx);
        pg8::EpiSwiglu E{F.H, FF, F.ssq2};
        pg8::gemm_phase<pg8::EpiSwiglu, pg8::StaticOrder, true, true>(F.lds, g, S, E); } SEAM(7);
    if (IN(8)) { pg8::Gemm g{F.H, F.WD2, M, D, FF}; pg8::StaticOrder S; S.init(M, D, F.G, bx);
        pg8::EpiResid<false> E{F.out, F.out, nullptr, F.ssq3, 0.5f};
        pg8::gemm_phase<pg8::EpiResid<false>, pg8::StaticOrder, true, true>(F.lds, g, S, E); } SEAM(8);
    if (IN(9)) { final_norm(F); }
#undef IN
#undef SEAM
}

extern "C" void kernel_launch(void* const* d_in, const int* in_sizes, int n_in, void* d_out, int out_size, void* d_ws, size_t ws_size, hipStream_t stream) {
    static int grid = 0;
    if (grid == 0) {
        if (n_in != 16 || in_sizes[0] != M * D || out_size != M * D || ws_size < WS_END) { fprintf(stderr, "kernel_launch: unexpected shapes (n_in %d, in0 %d, out %d, ws %zu)\n", n_in, n_in > 0 ? in_sizes[0] : -1, out_size, ws_size); grid = -1; return; }
        int dev = 0, cus = 0, per_cu = 0;
        if (hipGetDevice(&dev) != hipSuccess || hipDeviceGetAttribute(&cus, hipDeviceAttributeMultiprocessorCount, dev) != hipSuccess) { grid = -1; return; }
        if (hipFuncSetAttribute((const void*)fwd_kernel, hipFuncAttributeMaxDynamicSharedMemorySize, LDS_BYTES) != hipSuccess) { fprintf(stderr, "kernel_launch: hipFuncSetAttribute failed\n"); grid = -1; return; }
        if (hipOccupancyMaxActiveBlocksPerMultiprocessor(&per_cu, (const void*)fwd_kernel, NWAVES * 64, LDS_BYTES) != hipSuccess || per_cu < 1) { fprintf(stderr, "kernel_launch: occupancy query says %d\n", per_cu); per_cu = 1; }
        (void)hipGetLastError();
        grid = cus * per_cu;
    }
    if (grid < 0) return;
    Args a{};
    for (int i = 0; i < 16; ++i) a.in[i] = (const float*)d_in[i];
    a.out = (float*)d_out; a.ws = (unsigned char*)d_ws;
#if MK_N_LAUNCHES == 1
    a.ph_lo = 0; a.ph_hi = N_PHASES;
    void* kargs[] = {&a};
    hipError_t e = hipLaunchCooperativeKernel((const void*)fwd_kernel, dim3(grid), dim3(NWAVES * 64), kargs, LDS_BYTES, stream);
    if (e != hipSuccess) fprintf(stderr, "cooperative launch failed: %s (grid %d)\n", hipGetErrorString(e), grid);
#else
    for (int p = 0; p < N_PHASES; ++p) { a.ph_lo = p; a.ph_hi = p + 1;
        hipLaunchKernelGGL(fwd_kernel, dim3(grid), dim3(NWAVES * 64), LDS_BYTES, stream, a); }
#endif
}
```

```cpp
#include <hip/hip_runtime.h>
#include <hip/hip_cooperative_groups.h>
#include <cstdio>
#include <cstdint>
namespace cg = cooperative_groups;
namespace pg8 {
#define PG8_LAS __attribute__((address_space(3)))
typedef unsigned short bf16_t;
typedef short bf16x8 __attribute__((ext_vector_type(8)));
typedef float f32x4 __attribute__((ext_vector_type(4)));
typedef unsigned u32x4 __attribute__((ext_vector_type(4)));
constexpr int BM = 256, BK = 64, HALF = 128, HTB = HALF * BK * 2  , STAGE_BYTES = 8 * HTB, NXCD = 8, WGM = 8;

__host__ __device__ __forceinline__ int lds_byte(int r, int c) { const int st = (r >> 4) * 2 + (c >> 5), rr = r & 15, cc = c & 31, ob = rr * 64 + cc * 2; return st * 1024 + (ob ^ (((ob >> 9) & 1) << 5)); }
__host__ __device__ __forceinline__ void stage_rc(int b, int& R, int& C) { const int st = b / 1024, sb = b % 1024, swz = sb ^ (((sb >> 9) & 1) << 5); R = (st >> 1) * 16 + swz / 64; C = (st & 1) * 32 + (swz % 64) / 2; }
__host__ __device__ __forceinline__ int perm32(int rho) { const int n = rho >> 4, i = rho & 15; return 8 * (i >> 2) + 4 * n + (i & 3); }

struct Unit { int pm, pn; };
struct Gemm { const bf16_t* A; const bf16_t* Bt; int M, N, K; };

struct StaticOrder {
    int nM, nN, nwg, G, c;
    __host__ __device__ void init(int M, int N, int G_, int c_) { nM = M / BM; nN = N / BM; nwg = nM * nN; G = G_; c = c_; }
    __host__ __device__ bool next(int i, Unit& u) const {
        const long L = (long)i * G + c; if (L >= nwg) return false;
        int wgid = (int)L; { const int q = nwg / NXCD, r = nwg % NXCD, xcd = wgid % NXCD, off = wgid / NXCD; wgid = (xcd < r ? xcd * (q + 1) : r * (q + 1) + (xcd - r) * q) + off; }
        const int nig = WGM * nN, gid = wgid / nig, fm = gid * WGM, gsz = (nM - fm) < WGM ? (nM - fm) : WGM;
        u.pm = fm + ((wgid % nig) % gsz); u.pn = (wgid % nig) / gsz; return true;
    }
    __device__ __forceinline__ void a_ready(const Unit&) const {}
    __device__ __forceinline__ void done(const Unit&) const {}
};

__device__ __forceinline__ unsigned cvt_pk_bf16(float lo, float hi) { unsigned r; asm volatile("v_cvt_pk_bf16_f32 %0, %1, %2" : "=v"(r) : "v"(lo), "v"(hi)); return r; }
typedef float f32x2 __attribute__((ext_vector_type(2)));
constexpr float RMS_EPS = 1e-6f, INV_D = 1.0f / 1024.0f;
__device__ __forceinline__ float rms_rstd(const float* ssq, int row) { return 1.0f / sqrtf(ssq[row] * INV_D + RMS_EPS); }
__device__ __forceinline__ float silu_f(float x) { return x * __builtin_amdgcn_rcpf(1.0f + __builtin_amdgcn_exp2f(x * -1.44269504089f)); }

template <bool ROWS, bool COLS> struct EpiScaleBf16 {
    static constexpr bool PERM = true, AFTER_DRAIN = false;
    bf16_t* O; int ldc; int coff; const float* ssq; const float* cs;
    __device__ __forceinline__ void operator()(const f32x4 (&acc)[2][2][4][2], const Unit& u, int wr, int wc, int fr, int fq) const {
        const int row0 = u.pm * BM + wr * 64 + fr, col0 = u.pn * BM + wc * 32 + 8 * fq;
        f32x4 cv[2][2];
#pragma unroll
        for (int bj = 0; bj < 2; ++bj)
#pragma unroll
            for (int n = 0; n < 2; ++n) cv[bj][n] = COLS ? *(const f32x4*)(cs + col0 + bj * HALF + 4 * n) : (f32x4){1.f, 1.f, 1.f, 1.f};
#pragma unroll
        for (int ai = 0; ai < 2; ++ai)
#pragma unroll
            for (int m = 0; m < 4; ++m) { const int row = row0 + ai * HALF + m * 16; const float r = ROWS ? rms_rstd(ssq, row) : 1.f;
                bf16_t* rowp = O + (size_t)row * ldc + coff + col0;
#pragma unroll
                for (int bj = 0; bj < 2; ++bj) { f32x4 v0 = acc[ai][bj][m][0] * r, v1 = acc[ai][bj][m][1] * r;
                    if (COLS) { v0 = v0 * cv[bj][0]; v1 = v1 * cv[bj][1]; }
                    u32x4 w; w.x = cvt_pk_bf16(v0[0], v0[1]); w.y = cvt_pk_bf16(v0[2], v0[3]); w.z = cvt_pk_bf16(v1[0], v1[1]); w.w = cvt_pk_bf16(v1[2], v1[3]);
                    *(u32x4*)(rowp + bj * HALF) = w; } }
    }
};
struct EpiSwiglu {
    static constexpr bool PERM = true, AFTER_DRAIN = false;
    bf16_t* O; int ldc; const float* ssq;
    __device__ __forceinline__ void operator()(const f32x4 (&acc)[2][2][4][2], const Unit& u, int wr, int wc, int fr, int fq) const {
        const int row0 = u.pm * BM + wr * 64 + fr, col0 = u.pn * HALF + wc * 32 + 8 * fq;
#pragma unroll
        for (int ai = 0; ai < 2; ++ai)
#pragma unroll
            for (int m = 0; m < 4; ++m) { const int row = row0 + ai * HALF + m * 16; const float r = rms_rstd(ssq, row);
                const f32x4 g0 = acc[ai][0][m][0] * r, g1 = acc[ai][0][m][1] * r, u0 = acc[ai][1][m][0] * r, u1 = acc[ai][1][m][1] * r;
                f32x4 a0, a1;
#pragma unroll
                for (int e = 0; e < 4; ++e) { a0[e] = silu_f(g0[e]) * u0[e]; a1[e] = silu_f(g1[e]) * u1[e]; }
                u32x4 w; w.x = cvt_pk_bf16(a0[0], a0[1]); w.y = cvt_pk_bf16(a0[2], a0[3]); w.z = cvt_pk_bf16(a1[0], a1[1]); w.w = cvt_pk_bf16(a1[2], a1[3]);
                *(u32x4*)(O + (size_t)row * ldc + col0) = w; }
    }
};
template <bool WRITE_XB> struct EpiResid {
    static constexpr bool PERM = true, AFTER_DRAIN = false;
    const float* res; float* out; bf16_t* xb; float* ssq; float alpha;
    __device__ __forceinline__ void operator()(const f32x4 (&acc)[2][2][4][2], const Unit& u, int wr, int wc, int fr, int fq) const {
        const int row0 = u.pm * BM + wr * 64 + fr, col0 = u.pn * BM + wc * 32 + 8 * fq;
#pragma unroll
        for (int ai = 0; ai < 2; ++ai)
#pragma unroll
            for (int m = 0; m < 4; ++m) { const int row = row0 + ai * HALF + m * 16; const size_t off = (size_t)row * 1024 + col0; float s = 0.f;
#pragma unroll
                for (int bj = 0; bj < 2; ++bj) {
                    const f32x4 r0 = *(const f32x4*)(res + off + bj * HALF), r1 = *(const f32x4*)(res + off + bj * HALF + 4);
                    const f32x4 o0 = r0 + acc[ai][bj][m][0] * alpha, o1 = r1 + acc[ai][bj][m][1] * alpha;
                    *(f32x4*)(out + off + bj * HALF) = o0; *(f32x4*)(out + off + bj * HALF + 4) = o1;
                    s += (o0[0] * o0[0] + o0[1] * o0[1]) + (o0[2] * o0[2] + o0[3] * o0[3]) + (o1[0] * o1[0] + o1[1] * o1[1]) + (o1[2] * o1[2] + o1[3] * o1[3]);
                    if (WRITE_XB) { u32x4 w; w.x = cvt_pk_bf16(o0[0], o0[1]); w.y = cvt_pk_bf16(o0[2], o0[3]); w.z = cvt_pk_bf16(o1[0], o1[1]); w.w = cvt_pk_bf16(o1[2], o1[3]);
                        *(u32x4*)(xb + off + bj * HALF) = w; } }
                s += __shfl_xor(s, 16); s += __shfl_xor(s, 32);
                if (fq == 0) (void)__hip_atomic_fetch_add(ssq + row, s, __ATOMIC_RELAXED, __HIP_MEMORY_SCOPE_AGENT);
                asm volatile("" ::: "memory"); }
    }
};

template <class Epi, class Sched, bool ALIGN_EPI = false, bool SP2 = false>
__device__ __forceinline__ void gemm_phase(PG8_LAS unsigned char* lds, const Gemm g, const Sched& S, const Epi& E) {
    const int tid = threadIdx.x, wid = __builtin_amdgcn_readfirstlane(tid >> 6), lane = tid & 63, wr = wid >> 2, wc = wid & 3, fr = lane & 15, fq = lane >> 4;
    const int K = g.K, nt = K / BK;
    unsigned voffA[2], voffB[2];
#pragma unroll
    for (int i = 0; i < 2; ++i) { int R, C; stage_rc(tid * 16 + i * 8192, R, C); const int Rb = Epi::PERM ? ((R & ~31) + perm32(R & 31)) : R;
        voffA[i] = (unsigned)(R * K + C) * 2u; voffB[i] = (unsigned)(Rb * K + C) * 2u; }
    const size_t kstep = (size_t)(BK * 2);
    const size_t hstep = (size_t)HALF * K * 2;
    const size_t tstep = 2 * hstep;
    const unsigned ldsw = (unsigned)wid * 1024u;
    const int aoff = lds_byte(wr * 64 + fr, fq * 8), boff = lds_byte(wc * 32 + fr, fq * 8);
#define PG8_SA(b, h) (((b) * 2 + (h)) * HTB)
#define PG8_SB(b, h) ((4 + (b) * 2 + (h)) * HTB)
#define PG8_STAGE(bufoff, gbase, voff) do { _Pragma("unroll") for (int _i = 0; _i < 2; ++_i) \
        __builtin_amdgcn_global_load_lds((const unsigned*)((const char*)(gbase) + (voff)[_i]), (PG8_LAS unsigned*)(lds + (bufoff) + ldsw + _i * 8192), 16, 0, 0); } while (0)
#define PG8_LDA(dst, b, h) do { _Pragma("unroll") for (int m = 0; m < 4; ++m) _Pragma("unroll") for (int k = 0; k < 2; ++k) dst[m][k] = *(const PG8_LAS bf16x8*)(lds + PG8_SA(b, h) + aoff + m * 2048 + k * 1024); } while (0)
#define PG8_LDB(dst, b, h) do { _Pragma("unroll") for (int n = 0; n < 2; ++n) _Pragma("unroll") for (int k = 0; k < 2; ++k) dst[n][k] = *(const PG8_LAS bf16x8*)(lds + PG8_SB(b, h) + boff + n * 2048 + k * 1024); } while (0)
#define PG8_MMA(ai, bj, At, Bt) do { __builtin_amdgcn_s_setprio(1); _Pragma("unroll") for (int m = 0; m < 4; ++m) _Pragma("unroll") for (int n = 0; n < 2; ++n) _Pragma("unroll") for (int k = 0; k < 2; ++k) \
        acc[ai][bj][m][n] = __builtin_amdgcn_mfma_f32_16x16x32_bf16(Bt[n][k], At[m][k], acc[ai][bj][m][n], 0, 0, 0); __builtin_amdgcn_s_setprio(0); } while (0)
#define PG8_WAIT_V(n) asm volatile("s_waitcnt vmcnt(" #n ")" ::: "memory")
#define PG8_WAIT_L(n) asm volatile("s_waitcnt lgkmcnt(" #n ")" ::: "memory")
#define PG8_BAR __builtin_amdgcn_s_barrier()
#define PG8_SCHED __builtin_amdgcn_sched_barrier(0)
    Unit cur, nxt; int ui = 0;
    if (!S.next(0, cur)) return;
    f32x4 acc[2][2][4][2];
#pragma unroll
    for (int a = 0; a < 2; ++a)
#pragma unroll
        for (int b = 0; b < 2; ++b)
#pragma unroll
            for (int m = 0; m < 4; ++m)
#pragma unroll
                for (int n = 0; n < 2; ++n) acc[a][b][m][n] = (f32x4){0.f, 0.f, 0.f, 0.f};
    bf16x8 At[4][2], B0[2][2], B1[2][2];
    const char* cA = (const char*)g.A + (size_t)cur.pm * tstep; const char* cB = (const char*)g.Bt + (size_t)cur.pn * tstep;
    S.a_ready(cur);
    if constexpr (SP2) {
        PG8_STAGE(PG8_SB(0, 0), cB, voffB); PG8_STAGE(PG8_SB(0, 1), cB + hstep, voffB); PG8_STAGE(PG8_SA(0, 0), cA, voffA); PG8_STAGE(PG8_SA(0, 1), cA + hstep, voffA);
        if (wr == 1) PG8_BAR;
        PG8_WAIT_V(2); PG8_BAR;
        PG8_STAGE(PG8_SB(1, 0), cB + kstep, voffB); PG8_STAGE(PG8_SA(1, 0), cA + kstep, voffA); PG8_STAGE(PG8_SB(1, 1), cB + hstep + kstep, voffB);
        PG8_WAIT_V(6); PG8_BAR;
    } else {
        PG8_STAGE(PG8_SB(0, 0), cB, voffB); PG8_STAGE(PG8_SA(0, 0), cA, voffA); PG8_STAGE(PG8_SB(0, 1), cB + hstep, voffB); PG8_STAGE(PG8_SA(0, 1), cA + hstep, voffA);
        if (wr == 1) PG8_BAR;
        PG8_WAIT_V(4); PG8_BAR;
        PG8_STAGE(PG8_SB(1, 0), cB + kstep, voffB); PG8_STAGE(PG8_SA(1, 0), cA + kstep, voffA); PG8_STAGE(PG8_SB(1, 1), cB + hstep + kstep, voffB);
        PG8_WAIT_V(6); PG8_BAR;
    }
    for (;;) {
        const bool has_next = S.next(ui + 1, nxt);
        const char* nA = has_next ? (const char*)g.A + (size_t)nxt.pm * tstep : cA; const char* nB = has_next ? (const char*)g.Bt + (size_t)nxt.pn * tstep : cB;
        for (int t = 0; t < nt; t += 2) {
            const bool last = (t == nt - 2);
            const char* a1 = cA + (size_t)(t + 1) * kstep;
            const char* a2 = last ? nA : cA + (size_t)(t + 2) * kstep; const char* b2 = last ? nB : cB + (size_t)(t + 2) * kstep;
            const char* a3 = a2 + kstep; const char* b3 = b2 + kstep;
            if (last && has_next) S.a_ready(nxt);
            if constexpr (SP2) {
            PG8_LDB(B0, 0, 0); PG8_LDB(B1, 0, 1); PG8_SCHED; PG8_LDA(At, 0, 0); PG8_STAGE(PG8_SA(1, 1), a1 + hstep, voffA);
            PG8_WAIT_V(8); PG8_WAIT_L(0); PG8_BAR; PG8_MMA(0, 0, At, B0); PG8_MMA(0, 1, At, B1); PG8_BAR; PG8_SCHED;
            PG8_LDA(At, 0, 1); PG8_STAGE(PG8_SB(0, 0), b2, voffB); PG8_STAGE(PG8_SB(0, 1), b2 + hstep, voffB); PG8_STAGE(PG8_SA(0, 0), a2, voffA);
            PG8_WAIT_V(8); PG8_WAIT_L(0); PG8_BAR; PG8_MMA(1, 0, At, B0); PG8_MMA(1, 1, At, B1); PG8_BAR; PG8_SCHED;
            PG8_LDB(B0, 1, 0); PG8_LDB(B1, 1, 1); PG8_SCHED; PG8_LDA(At, 1, 0); PG8_STAGE(PG8_SA(0, 1), a2 + hstep, voffA);
            PG8_WAIT_V(8); PG8_WAIT_L(0); PG8_BAR; PG8_MMA(0, 0, At, B0); PG8_MMA(0, 1, At, B1); PG8_BAR; PG8_SCHED;
            PG8_LDA(At, 1, 1); PG8_STAGE(PG8_SB(1, 0), b3, voffB); PG8_STAGE(PG8_SB(1, 1), b3 + hstep, voffB); PG8_STAGE(PG8_SA(1, 0), a3, voffA);
            PG8_WAIT_V(8); PG8_WAIT_L(0); PG8_BAR; PG8_MMA(1, 0, At, B0); PG8_MMA(1, 1, At, B1); PG8_BAR; PG8_SCHED;
            } else {
            PG8_LDB(B0, 0, 0); PG8_SCHED; PG8_LDA(At, 0, 0); PG8_STAGE(PG8_SA(1, 1), a1 + hstep, voffA);
            PG8_WAIT_L(8); PG8_BAR; PG8_WAIT_L(0); PG8_MMA(0, 0, At, B0); PG8_BAR; PG8_SCHED;
            PG8_LDB(B1, 0, 1); PG8_STAGE(PG8_SB(0, 0), b2, voffB);
            PG8_BAR; PG8_WAIT_L(0); PG8_MMA(0, 1, At, B1); PG8_BAR;
            PG8_LDA(At, 0, 1); PG8_STAGE(PG8_SA(0, 0), a2, voffA);
            PG8_BAR; PG8_WAIT_L(0); PG8_MMA(1, 0, At, B0); PG8_BAR; PG8_SCHED;
            PG8_STAGE(PG8_SB(0, 1), b2 + hstep, voffB);
            PG8_WAIT_V(6); PG8_BAR; PG8_MMA(1, 1, At, B1); PG8_BAR;
            PG8_LDB(B0, 1, 0); PG8_SCHED; PG8_LDA(At, 1, 0); PG8_STAGE(PG8_SA(0, 1), a2 + hstep, voffA);
            PG8_WAIT_L(8); PG8_BAR; PG8_WAIT_L(0); PG8_MMA(0, 0, At, B0); PG8_BAR; PG8_SCHED;
            PG8_LDB(B1, 1, 1); PG8_STAGE(PG8_SB(1, 0), b3, voffB);
            PG8_BAR; PG8_WAIT_L(0); PG8_MMA(0, 1, At, B1); PG8_BAR;
            PG8_LDA(At, 1, 1); PG8_STAGE(PG8_SA(1, 0), a3, voffA);
            PG8_BAR; PG8_WAIT_L(0); PG8_MMA(1, 0, At, B0); PG8_BAR; PG8_SCHED;
            PG8_STAGE(PG8_SB(1, 1), b3 + hstep, voffB);
            PG8_WAIT_V(6); PG8_BAR; PG8_MMA(1, 1, At, B1); PG8_BAR;
            }
        }
        if constexpr (ALIGN_EPI) { if (wr == 0) PG8_BAR; }
        if constexpr (!Epi::AFTER_DRAIN) { E(acc, cur, wr, wc, fr, fq); S.done(cur); }
        if (!has_next) break;
#pragma unroll
        for (int a = 0; a < 2; ++a)
#pragma unroll
            for (int b = 0; b < 2; ++b)
#pragma unroll
                for (int m = 0; m < 4; ++m)
#pragma unroll
                    for (int n = 0; n < 2; ++n) acc[a][b][m][n] = (f32x4){0.f, 0.f, 0.f, 0.f};
        cur = nxt; cA = nA; cB = nB; ++ui;
        if constexpr (ALIGN_EPI) { if (wr == 1) PG8_BAR; }
    }
    PG8_WAIT_V(0);
    if constexpr (!ALIGN_EPI) { if (wr == 0) PG8_BAR; }
    PG8_BAR;
    if constexpr (Epi::AFTER_DRAIN) { E.fused(acc, cur, wr, wc, fr, fq, lds, wid, lane); S.done(cur); }
#undef PG8_SA
#undef PG8_SB
#undef PG8_STAGE
#undef PG8_LDA
#undef PG8_LDB
#undef PG8_MMA
#undef PG8_WAIT_V
#undef PG8_WAIT_L
#undef PG8_BAR
#undef PG8_SCHED
}
}

#ifndef MK_N_LAUNCHES
#define MK_N_LAUNCHES 1
#endif
constexpr int NWAVES = 8;
constexpr int BATCH = 4, SEQ = 4096, D = 1024, FF = 2816, DCONV = 512, DPOOL = 512, NPROJ = 2048;
constexpr int M = BATCH * SEQ;
constexpr int N_PHASES = 10;
constexpr size_t MiB = 1u << 20;
constexpr size_t WS_SSQ = 0, WS_BAR = 512 * 1024;
constexpr size_t WS_WGU1 = 2 * MiB, WS_WD1 = 13 * MiB, WS_WIN = 19 * MiB, WS_WPOOL = 23 * MiB, WS_WOUT = 24 * MiB, WS_WGU2 = 26 * MiB, WS_WD2 = 37 * MiB;
constexpr size_t WS_XB = 44 * MiB;
constexpr size_t WS_H = 76 * MiB;
constexpr size_t WS_PROJ = 76 * MiB, WS_POOLED = 140 * MiB;
constexpr size_t WS_YC = 164 * MiB, WS_END = 196 * MiB;
static_assert(WS_WGU1 + (size_t)2 * FF * D * 2 <= WS_WD1 && WS_WD1 + (size_t)D * FF * 2 <= WS_WIN && WS_WGU2 + (size_t)2 * FF * D * 2 <= WS_WD2 && WS_WD2 + (size_t)D * FF * 2 <= WS_XB, "ws map");
static_assert(WS_H + (size_t)M * FF * 2 <= WS_YC && WS_POOLED + (size_t)M * DPOOL * 2 <= WS_YC && WS_PROJ + (size_t)M * NPROJ * 2 <= WS_POOLED, "ws map");
constexpr int MISC_OFF = 131072 + 1024;
constexpr int LDS_BYTES = 147456;

#define GAS __attribute__((address_space(1)))
#define LAS __attribute__((address_space(3)))
typedef unsigned short bf16;
typedef unsigned v4u __attribute__((ext_vector_type(4)));
typedef unsigned v2u __attribute__((ext_vector_type(2)));
typedef float f32x4 __attribute__((ext_vector_type(4)));
#define LDS_WAIT() asm volatile("s_waitcnt lgkmcnt(0)" ::: "memory")
using pg8::cvt_pk_bf16;

#define XB_TMO      128
#define XB_XCNT(j)  (256  + 64 * (j))
#define XB_XSUB(j)  (1280 + 64 * (j))
#define XB_XGEN(j)  (2304 + 64 * (j))
#define XB_TOP      3328
#define XB_TOPGEN   3392
#define XCD_BAR_WORDS 3456
#define XB_SPIN_CAP (1u << 18)

__device__ __forceinline__ unsigned xb_ld(unsigned* p)              { return __hip_atomic_load(p, __ATOMIC_RELAXED, __HIP_MEMORY_SCOPE_AGENT); }
__device__ __forceinline__ unsigned xb_add(unsigned* p, unsigned v) { return __hip_atomic_fetch_add(p, v, __ATOMIC_RELAXED, __HIP_MEMORY_SCOPE_AGENT); }
__device__ __forceinline__ unsigned xb_xcc_id() { return (unsigned)__builtin_amdgcn_s_getreg((3 << 11) | 20) & 0xFu; }
#define XB_SPIN(cond, bar) do { unsigned _sp = 0; while (cond) { __builtin_amdgcn_s_sleep(1); \
    if ((++_sp & 255u) == 0u) { if (xb_ld(&(bar)[XB_TMO])) break; if (_sp > XB_SPIN_CAP) { atomicAdd(&(bar)[XB_TMO], 1u); break; } } } } while (0)

struct XcdBarrier {
    unsigned* bar; unsigned x;
    volatile LAS unsigned* st;
};

__device__ __forceinline__ XcdBarrier xcd_barrier_post(unsigned* bar, volatile LAS unsigned* st) {
    XcdBarrier b; b.bar = bar; b.x = xb_xcc_id(); b.st = st;
    if (threadIdx.x == 0) (void)xb_add(&bar[XB_XCNT(b.x)], 1u);
    return b;
}
__device__ __forceinline__ void xcd_barrier_complete(unsigned* bar, unsigned x, unsigned& nloc, unsigned& nx) {
    const unsigned G = gridDim.x * gridDim.y * gridDim.z;
    unsigned sum, cnt, mine, sp = 0u;
    for (;;) {
        sum = 0u; cnt = 0u; mine = 0u;
#pragma unroll
        for (unsigned j = 0; j < 16; ++j) { const unsigned c = xb_ld(&bar[XB_XCNT(j)]); sum += c; cnt += (c > 0u) ? 1u : 0u; mine = (j == x) ? c : mine; }
        if (sum == G) break;
        __builtin_amdgcn_s_sleep(1);
        if ((++sp & 255u) == 0u) { if (xb_ld(&bar[XB_TMO])) break; if (sp > XB_SPIN_CAP) { atomicAdd(&bar[XB_TMO], 1u); break; } }
    }
    nloc = mine > 0u ? mine : 1u; nx = cnt > 0u ? cnt : 1u;
}

__device__ __forceinline__ void xcd_barrier(const XcdBarrier& b) {
    asm volatile("s_waitcnt vmcnt(0)" ::: "memory");
    __syncthreads();
    if (threadIdx.x == 0) {
        unsigned* bar = b.bar;
        __builtin_amdgcn_s_waitcnt(0);
        unsigned nloc = b.st[0], nx = b.st[1];
        if (nloc == 0u) { xcd_barrier_complete(bar, b.x, nloc, nx); b.st[0] = nloc; b.st[1] = nx; }
        const unsigned old = xb_add(&bar[XB_XSUB(b.x)], 1u);
        const unsigned gen = old / nloc;
        if (old + 1u == (gen + 1u) * nloc) {
            __builtin_amdgcn_fence(__ATOMIC_RELEASE, "agent");
            asm volatile("s_waitcnt vmcnt(0)" ::: "memory");
            const unsigned og = xb_add(&bar[XB_TOP], 1u);
            const unsigned tg = og / nx;
            if (og + 1u == (tg + 1u) * nx) xb_add(&bar[XB_TOPGEN], 1u);
            else XB_SPIN(xb_ld(&bar[XB_TOPGEN]) == tg, bar);
            __builtin_amdgcn_fence(__ATOMIC_ACQUIRE, "agent");
            xb_add(&bar[XB_XGEN(b.x)], 1u);
            asm volatile("s_waitcnt vmcnt(0)" ::: "memory");
        } else {
            XB_SPIN(xb_ld(&bar[XB_XGEN(b.x)]) == gen, bar);
            __builtin_amdgcn_fence(__ATOMIC_ACQUIRE, "agent");
            asm volatile("s_waitcnt vmcnt(0)" ::: "memory");
        }
    }
    __syncthreads();
}

struct Frame {
    LAS unsigned char* lds;
    int tid, lane, wave, vcu, G;
    const float *x, *g1, *wg1, *wu1, *wd1, *gmix, *win, *convw, *poolw, *pscale, *wout, *g2, *wg2, *wu2, *wd2, *gfin;
    float* out; float *ssq0, *ssq1, *ssq2, *ssq3;
    bf16 *WGU1, *WD1, *WIN, *WPOOL, *WOUT, *WGU2, *WD2, *XB, *H, *PROJ, *POOLED, *YC;
};

__device__ __forceinline__ float wave_sum(float v) {
#pragma unroll
    for (int o = 1; o < 64; o <<= 1) v += __shfl_xor(v, o);
    return v;
}
__device__ __forceinline__ void p0_transpose_item(const float* W, int K, int N, bf16* WT, int mode, const float* gk, LAS float* scr, int item, int lane) {
    const int nblk = N / 32, kb = item / nblk, nb = item % nblk, k0 = 64 * kb, n0 = 32 * nb;
#pragma unroll 8
    for (int i = 0; i < 32; ++i) { const int kk = 2 * i + (lane >> 5); const float s = gk ? gk[k0 + kk] : 1.f; scr[kk * 33 + (lane & 31)] = W[(size_t)(k0 + kk) * N + n0 + (lane & 31)] * s; }
    LDS_WAIT(); asm volatile("" ::: "memory");
    const int c = lane & 7;
    const int d0 = (mode == 0) ? n0 : ((n0 >> 7) * 256 + (n0 & 127) + (mode == 2 ? 128 : 0));
#pragma unroll
    for (int j = 0; j < 4; ++j) { const int n = (lane >> 3) + 8 * j; const LAS float* s = scr + (8 * c) * 33 + n;
        v4u o; o.x = cvt_pk_bf16(s[0 * 33], s[1 * 33]); o.y = cvt_pk_bf16(s[2 * 33], s[3 * 33]); o.z = cvt_pk_bf16(s[4 * 33], s[5 * 33]); o.w = cvt_pk_bf16(s[6 * 33], s[7 * 33]);
        *(GAS v4u*)(WT + (size_t)(d0 + n) * K + k0 + 8 * c) = o; }
    LDS_WAIT(); asm volatile("" ::: "memory");
}
__device__ __forceinline__ void p0_prologue(Frame& F) {
    LAS float* scr = (LAS float*)(F.lds + F.wave * 16384);
    const int gw = F.vcu * NWAVES + F.wave, NGW = F.G * NWAVES;
    constexpr int I_GU = (D / 64) * (FF / 32), I_DN = (FF / 64) * (D / 32), I_IN = (D / 64) * (NPROJ / 32), I_OUT = (D / 64) * (D / 32);
    constexpr int NITEMS = 4 * I_GU + 2 * I_DN + I_IN + I_OUT;
    for (int it = gw; it < NITEMS; it += NGW) {
        int r = it;
        if (r < I_GU) { p0_transpose_item(F.wg1, D, FF, F.WGU1, 1, F.g1, scr, r, F.lane); continue; } r -= I_GU;
        if (r < I_GU) { p0_transpose_item(F.wu1, D, FF, F.WGU1, 2, F.g1, scr, r, F.lane); continue; } r -= I_GU;
        if (r < I_GU) { p0_transpose_item(F.wg2, D, FF, F.WGU2, 1, F.g2, scr, r, F.lane); continue; } r -= I_GU;
        if (r < I_GU) { p0_transpose_item(F.wu2, D, FF, F.WGU2, 2, F.g2, scr, r, F.lane); continue; } r -= I_GU;
        if (r < I_DN) { p0_transpose_item(F.wd1, FF, D, F.WD1, 0, nullptr, scr, r, F.lane); continue; } r -= I_DN;
        if (r < I_DN) { p0_transpose_item(F.wd2, FF, D, F.WD2, 0, nullptr, scr, r, F.lane); continue; } r -= I_DN;
        if (r < I_IN) { p0_transpose_item(F.win, D, NPROJ, F.WIN, 0, F.gmix, scr, r, F.lane); continue; } r -= I_IN;
        p0_transpose_item(F.wout, D, D, F.WOUT, 0, nullptr, scr, r, F.lane);
    }
    const int gt = F.vcu * (NWAVES * 64) + F.tid, NGT = F.G * NWAVES * 64;
    for (int idx = gt; idx < DPOOL * DPOOL; idx += NGT) { const int n = idx >> 9, k = idx & 511; const int gn = n >> 7, gk = k >> 7;
        const float v = (gn == gk) ? F.poolw[(size_t)gn * 16384 + (k & 127) * 128 + (n & 127)] : 0.f;
        F.WPOOL[idx] = (bf16)(cvt_pk_bf16(v, 0.f) & 0xffffu); }
    for (int idx = gt; idx < 3 * M; idx += NGT) F.ssq1[idx] = 0.f;
    for (int m = gw; m < M; m += NGW) {
        const GAS f32x4* xr = (const GAS f32x4*)(F.x + (size_t)m * D) + F.lane;
        f32x4 v[4]; float s = 0.f;
#pragma unroll
        for (int j = 0; j < 4; ++j) { v[j] = xr[64 * j]; s += (v[j].x * v[j].x + v[j].y * v[j].y) + (v[j].z * v[j].z + v[j].w * v[j].w); }
        s = wave_sum(s);
        if (F.lane == 0) F.ssq0[m] = s;
        GAS v2u* o8 = (GAS v2u*)(F.XB + (size_t)m * D) + F.lane;
#pragma unroll
        for (int j = 0; j < 4; ++j) { v2u o; o.x = cvt_pk_bf16(v[j].x, v[j].y); o.y = cvt_pk_bf16(v[j].z, v[j].w); o8[64 * j] = o; }
    }
}
__device__ __forceinline__ void unpack8(const v4u q, float (&f)[8]) {
    f[0] = __uint_as_float(q.x << 16); f[1] = __uint_as_float(q.x & 0xffff0000u); f[2] = __uint_as_float(q.y << 16); f[3] = __uint_as_float(q.y & 0xffff0000u);
    f[4] = __uint_as_float(q.z << 16); f[5] = __uint_as_float(q.z & 0xffff0000u); f[6] = __uint_as_float(q.w << 16); f[7] = __uint_as_float(q.w & 0xffff0000u);
}
__device__ __forceinline__ v4u pack8(const float (&f)[8]) { v4u o; o.x = cvt_pk_bf16(f[0], f[1]); o.y = cvt_pk_bf16(f[2], f[3]); o.z = cvt_pk_bf16(f[4], f[5]); o.w = cvt_pk_bf16(f[6], f[7]); return o; }
__device__ __forceinline__ void mix_phase(Frame& F) {
    const int lane = F.lane, c8 = lane * 8, w = 2 << (lane >> 4);
    float w0[8], w1[8], w2[8];
#pragma unroll
    for (int e = 0; e < 8; ++e) { w0[e] = F.convw[c8 + e]; w1[e] = F.convw[DCONV + c8 + e]; w2[e] = F.convw[2 * DCONV + c8 + e]; }
    const int gw = F.vcu * NWAVES + F.wave, NGW = F.G * NWAVES;
    for (int item = gw; item < M / 8; item += NGW) {
        const int t0 = item * 8, p0 = t0 & (SEQ - 1);
        const bf16* prow = F.PROJ + (size_t)t0 * NPROJ + c8;
        float z1[8], z2[8];
#pragma unroll
        for (int e = 0; e < 8; ++e) { z1[e] = 0.f; z2[e] = 0.f; }
        if (p0 > 0) { float a[8], b[8];
            unpack8(*(const GAS v4u*)(prow - 2 * NPROJ), a); unpack8(*(const GAS v4u*)(prow - 2 * NPROJ + 1024), b);
#pragma unroll
            for (int e = 0; e < 8; ++e) z2[e] = a[e] * b[e];
            unpack8(*(const GAS v4u*)(prow - NPROJ), a); unpack8(*(const GAS v4u*)(prow - NPROJ + 1024), b);
#pragma unroll
            for (int e = 0; e < 8; ++e) z1[e] = a[e] * b[e]; }
#pragma unroll
        for (int j = 0; j < 8; ++j) { float a[8], b[8], c[8], y[8];
            unpack8(*(const GAS v4u*)(prow + j * NPROJ), a); unpack8(*(const GAS v4u*)(prow + j * NPROJ + 512), b); unpack8(*(const GAS v4u*)(prow + j * NPROJ + 1024), c);
#pragma unroll
            for (int e = 0; e < 8; ++e) { const float z0 = c[e] * a[e]; y[e] = b[e] * (w0[e] * z2[e] + w1[e] * z1[e] + w2[e] * z0); z2[e] = z1[e]; z1[e] = z0; }
            *(GAS v4u*)(F.YC + (size_t)(t0 + j) * D + c8) = pack8(y); }
        const bf16* urow = prow + 1536;
        float S[8];
#pragma unroll
        for (int e = 0; e < 8; ++e) S[e] = 0.f;
#pragma unroll
        for (int i = 15; i >= 1; --i) if (i < w && p0 - i >= 0) { float a[8]; unpack8(*(const GAS v4u*)(urow - i * NPROJ), a);
#pragma unroll
            for (int e = 0; e < 8; ++e) S[e] += a[e]; }
#pragma unroll
        for (int j = 0; j < 8; ++j) { float a[8], y[8]; unpack8(*(const GAS v4u*)(urow + j * NPROJ), a);
            const int cnt = (p0 + j + 1) < w ? (p0 + j + 1) : w; const float inv = 1.0f / (float)cnt;
#pragma unroll
            for (int e = 0; e < 8; ++e) { S[e] += a[e]; y[e] = S[e] * inv - a[e]; }
            *(GAS v4u*)(F.POOLED + (size_t)(t0 + j) * DPOOL + c8) = pack8(y);
            const int idx = j - (w - 1);
            if (p0 + idx >= 0) { float o[8]; unpack8(*(const GAS v4u*)(urow + idx * NPROJ), o);
#pragma unroll
                for (int e = 0; e < 8; ++e) S[e] -= o[e]; } }
    }
}
__device__ __forceinline__ void final_norm(Frame& F) {
    const int gw = F.vcu * NWAVES + F.wave, NGW = F.G * NWAVES;
    f32x4 gf[4];
#pragma unroll
    for (int j = 0; j < 4; ++j) gf[j] = ((const GAS f32x4*)F.gfin)[64 * j + F.lane];
    for (int m = gw; m < M; m += NGW) { const float r = pg8::rms_rstd(F.ssq3, m);
        GAS f32x4* xr = (GAS f32x4*)(F.out + (size_t)m * D) + F.lane;
#pragma unroll
        for (int j = 0; j < 4; ++j) { const f32x4 v = xr[64 * j]; xr[64 * j] = v * r * gf[j]; } }
}

struct Args { const float* in[16]; float* out; unsigned char* ws; int ph_lo, ph_hi; };
__global__ void __launch_bounds__(NWAVES * 64, 2) fwd_kernel(Args args) {
    extern __shared__ __attribute__((aligned(16))) unsigned char lds[];
    cg::grid_group grid = cg::this_grid();
    Frame F;
    F.lds = (LAS unsigned char*)lds;
    F.tid = threadIdx.x; F.lane = F.tid & 63; F.wave = __builtin_amdgcn_readfirstlane(F.tid >> 6);
    F.G = gridDim.x; { const int bx = blockIdx.x; F.vcu = (F.G % 8 == 0) ? (bx % 8) * (F.G / 8) + bx / 8 : bx; }
    unsigned char* ws = args.ws;
    F.x = args.in[0]; F.g1 = args.in[1]; F.wg1 = args.in[2]; F.wu1 = args.in[3]; F.wd1 = args.in[4]; F.gmix = args.in[5]; F.win = args.in[6]; F.convw = args.in[7];
    F.poolw = args.in[8]; F.pscale = args.in[9]; F.wout = args.in[10]; F.g2 = args.in[11]; F.wg2 = args.in[12]; F.wu2 = args.in[13]; F.wd2 = args.in[14]; F.gfin = args.in[15];
    F.out = args.out;
    F.ssq0 = (float*)(ws + WS_SSQ); F.ssq1 = F.ssq0 + M; F.ssq2 = F.ssq1 + M; F.ssq3 = F.ssq2 + M;
    F.WGU1 = (bf16*)(ws + WS_WGU1); F.WD1 = (bf16*)(ws + WS_WD1); F.WIN = (bf16*)(ws + WS_WIN); F.WPOOL = (bf16*)(ws + WS_WPOOL); F.WOUT = (bf16*)(ws + WS_WOUT);
    F.WGU2 = (bf16*)(ws + WS_WGU2); F.WD2 = (bf16*)(ws + WS_WD2); F.XB = (bf16*)(ws + WS_XB); F.H = (bf16*)(ws + WS_H); F.PROJ = (bf16*)(ws + WS_PROJ);
    F.POOLED = (bf16*)(ws + WS_POOLED); F.YC = (bf16*)(ws + WS_YC);
    const int lo = args.ph_lo, hi = args.ph_hi;
    volatile LAS unsigned* MISC = (volatile LAS unsigned*)(F.lds + MISC_OFF);
    if (F.tid < 32) MISC[F.tid] = 0u;
    __syncthreads();
    unsigned* barw = (unsigned*)(ws + WS_BAR);
    XcdBarrier bar; bar.bar = barw; bar.x = 0; bar.st = nullptr;
#define IN(k) (lo <= (k) && (k) < hi)
#define SEAM(k) do { if (IN(k) && IN((k) + 1)) xcd_barrier(bar); } while (0)
    const int bx = (int)blockIdx.x;
    if (hi > lo + 1) bar = xcd_barrier_post(barw, MISC + 8);
    if (lo < 0) grid.sync();
    if (IN(0)) { p0_prologue(F); } SEAM(0);
    if (IN(1)) { pg8::Gemm g{F.XB, F.WGU1, M, 2 * FF, D}; pg8::StaticOrder S; S.init(M, 2 * FF, F.G, bx);
        pg8::EpiSwiglu E{F.H, FF, F.ssq0};
        pg8::gemm_phase<pg8::EpiSwiglu, pg8::StaticOrder, true, true>(F.lds, g, S, E); } SEAM(1);
    if (IN(2)) { pg8::Gemm g{F.H, F.WD1, M, D, FF}; pg8::StaticOrder S; S.init(M, D, F.G, bx);
        pg8::EpiResid<true> E{F.x, F.out, F.XB, F.ssq1, 0.5f};
        pg8::gemm_phase<pg8::EpiResid<true>, pg8::StaticOrder, true, true>(F.lds, g, S, E); } SEAM(2);
    if (IN(3)) { pg8::Gemm g{F.XB, F.WIN, M, NPROJ, D}; pg8::StaticOrder S; S.init(M, NPROJ, F.G, bx);
        pg8::EpiScaleBf16<true, false> E{F.PROJ, NPROJ, 0, F.ssq1, nullptr};
        pg8::gemm_phase<pg8::EpiScaleBf16<true, false>, pg8::StaticOrder, true, true>(F.lds, g, S, E); } SEAM(3);
    if (IN(4)) { mix_phase(F); } SEAM(4);
    if (IN(5)) { pg8::Gemm g{F.POOLED, F.WPOOL, M, DPOOL, DPOOL}; pg8::StaticOrder S; S.init(M, DPOOL, F.G, bx);
        pg8::EpiScaleBf16<false, true> E{F.YC, D, DCONV, nullptr, F.pscale};
        pg8::gemm_phase<pg8::EpiScaleBf16<false, true>, pg8::StaticOrder, true, true>(F.lds, g, S, E); } SEAM(5);
    if (IN(6)) { pg8::Gemm g{F.YC, F.WOUT, M, D, D}; pg8::StaticOrder S; S.init(M, D, F.G, bx);
        pg8::EpiResid<true> E{F.out, F.out, F.XB, F.ssq2, 1.0f};
        pg8::gemm_phase<pg8::EpiResid<true>, pg8::StaticOrder, true, true>(F.lds, g, S, E); } SEAM(6);
    if (IN(7)) { pg8::Gemm g{F.XB, F.WGU2, M, 2 * FF, D}; pg8::StaticOrder S; S.init(M, 2 * FF, F.G, bx);
        pg8::EpiSwiglu E{F.H, FF, F.ssq2};
        pg8::gemm_phase<pg8::EpiSwiglu, pg8::StaticOrder, true, true>(F.lds, g, S, E); } SEAM(7);
    if (IN(8)) { pg8::Gemm g{F.H, F.WD2, M, D, FF}; pg8::StaticOrder S; S.init(M, D, F.G, bx);
        pg8::EpiResid<false> E{F.out, F.out, nullptr, F.ssq3, 0.5f};
        pg8::gemm_phase<pg8::EpiResid<false>, pg8::StaticOrder, true, true>(F.lds, g, S, E); } SEAM(8);
    if (IN(9)) { final_norm(F); }
#undef IN
#undef SEAM
}

extern "C" void kernel_launch(void* const* d_in, const int* in_sizes, int n_in, void* d_out, int out_size, void* d_ws, size_t ws_size, hipStream_t stream) {
    static int grid = 0;
    if (grid == 0) {
        if (n_in != 16 || in_sizes[0] != M * D || out_size != M * D || ws_size < WS_END) { fprintf(stderr, "kernel_launch: unexpected shapes (n_in %d, in0 %d, out %d, ws %zu)\n", n_in, n_in > 0 ? in_sizes[0] : -1, out_size, ws_size); grid = -1; return; }
        int dev = 0, cus = 0, per_cu = 0;
        if (hipGetDevice(&dev) != hipSuccess || hipDeviceGetAttribute(&cus, hipDeviceAttributeMultiprocessorCount, dev) != hipSuccess) { grid = -1; return; }
        if (hipFuncSetAttribute((const void*)fwd_kernel, hipFuncAttributeMaxDynamicSharedMemorySize, LDS_BYTES) != hipSuccess) { fprintf(stderr, "kernel_launch: hipFuncSetAttribute failed\n"); grid = -1; return; }
        if (hipOccupancyMaxActiveBlocksPerMultiprocessor(&per_cu, (const void*)fwd_kernel, NWAVES * 64, LDS_BYTES) != hipSuccess || per_cu < 1) { fprintf(stderr, "kernel_launch: occupancy query says %d\n", per_cu); per_cu = 1; }
        (void)hipGetLastError();
        grid = cus * per_cu;
    }
    if (grid < 0) return;
    if (hipMemsetAsync((char*)d_ws + WS_BAR, 0, XCD_BAR_WORDS * 4, stream) != hipSuccess) { fprintf(stderr, "kernel_launch: memset failed\n"); return; }
    Args a{};
    for (int i = 0; i < 16; ++i) a.in[i] = (const float*)d_in[i];
    a.out = (float*)d_out; a.ws = (unsigned char*)d_ws;
#if MK_N_LAUNCHES == 1
    a.ph_lo = 0; a.ph_hi = N_PHASES;
    void* kargs[] = {&a};
    hipError_t e = hipLaunchCooperativeKernel((const void*)fwd_kernel, dim3(grid), dim3(NWAVES * 64), kargs, LDS_BYTES, stream);
    if (e != hipSuccess) fprintf(stderr, "cooperative launch failed: %s (grid %d)\n", hipGetErrorString(e), grid);
#else
    for (int p = 0; p < N_PHASES; ++p) { a.ph_lo = p; a.ph_hi = p + 1;
        hipLaunchKernelGGL(fwd_kernel, dim3(grid), dim3(NWAVES * 64), LDS_BYTES, stream, a); }
#endif
}
```

```cpp
#include <hip/hip_runtime.h>
#include <hip/hip_cooperative_groups.h>
#include <cstdio>
#include <cstdint>
namespace cg = cooperative_groups;
namespace pg8 {
#define PG8_LAS __attribute__((address_space(3)))
typedef unsigned short bf16_t;
typedef short bf16x8 __attribute__((ext_vector_type(8)));
typedef float f32x4 __attribute__((ext_vector_type(4)));
typedef unsigned u32x4 __attribute__((ext_vector_type(4)));
constexpr int BM = 256, BK = 64, HALF = 128, HTB = HALF * BK * 2  , STAGE_BYTES = 8 * HTB, NXCD = 8, WGM = 8;

__host__ __device__ __forceinline__ int lds_byte(int r, int c) { const int st = (r >> 4) * 2 + (c >> 5), rr = r & 15, cc = c & 31, ob = rr * 64 + cc * 2; return st * 1024 + (ob ^ (((ob >> 9) & 1) << 5)); }
__host__ __device__ __forceinline__ void stage_rc(int b, int& R, int& C) { const int st = b / 1024, sb = b % 1024, swz = sb ^ (((sb >> 9) & 1) << 5); R = (st >> 1) * 16 + swz / 64; C = (st & 1) * 32 + (swz % 64) / 2; }
__host__ __device__ __forceinline__ int perm32(int rho) { const int n = rho >> 4, i = rho & 15; return 8 * (i >> 2) + 4 * n + (i & 3); }

struct Unit { int pm, pn; };
struct Gemm { const bf16_t* A; const bf16_t* Bt; int M, N, K; };

struct StaticOrder {
    int nM, nN, nwg, G, c;
    __host__ __device__ void init(int M, int N, int G_, int c_) { nM = M / BM; nN = N / BM; nwg = nM * nN; G = G_; c = c_; }
    __host__ __device__ bool next(int i, Unit& u) const {
        const long L = (long)i * G + c; if (L >= nwg) return false;
        int wgid = (int)L; { const int q = nwg / NXCD, r = nwg % NXCD, xcd = wgid % NXCD, off = wgid / NXCD; wgid = (xcd < r ? xcd * (q + 1) : r * (q + 1) + (xcd - r) * q) + off; }
        const int nig = WGM * nN, gid = wgid / nig, fm = gid * WGM, gsz = (nM - fm) < WGM ? (nM - fm) : WGM;
        u.pm = fm + ((wgid % nig) % gsz); u.pn = (wgid % nig) / gsz; return true;
    }
    __device__ __forceinline__ void a_ready(const Unit&) const {}
    __device__ __forceinline__ void done(const Unit&) const {}
};

__device__ __forceinline__ unsigned cvt_pk_bf16(float lo, float hi) { unsigned r; asm volatile("v_cvt_pk_bf16_f32 %0, %1, %2" : "=v"(r) : "v"(lo), "v"(hi)); return r; }
typedef float f32x2 __attribute__((ext_vector_type(2)));
constexpr float RMS_EPS = 1e-6f, INV_D = 1.0f / 1024.0f;
__device__ __forceinline__ float rms_rstd(const float* ssq, int row) { return 1.0f / sqrtf(ssq[row] * INV_D + RMS_EPS); }
__device__ __forceinline__ float silu_f(float x) { return x * __builtin_amdgcn_rcpf(1.0f + __builtin_amdgcn_exp2f(x * -1.44269504089f)); }

template <bool ROWS, bool COLS> struct EpiScaleBf16 {
    static constexpr bool PERM = true, AFTER_DRAIN = false;
    bf16_t* O; int ldc; int coff; const float* ssq; const float* cs;
    __device__ __forceinline__ void operator()(const f32x4 (&acc)[2][2][4][2], const Unit& u, int wr, int wc, int fr, int fq) const {
        const int row0 = u.pm * BM + wr * 64 + fr, col0 = u.pn * BM + wc * 32 + 8 * fq;
        f32x4 cv[2][2];
#pragma unroll
        for (int bj = 0; bj < 2; ++bj)
#pragma unroll
            for (int n = 0; n < 2; ++n) cv[bj][n] = COLS ? *(const f32x4*)(cs + col0 + bj * HALF + 4 * n) : (f32x4){1.f, 1.f, 1.f, 1.f};
#pragma unroll
        for (int ai = 0; ai < 2; ++ai)
#pragma unroll
            for (int m = 0; m < 4; ++m) { const int row = row0 + ai * HALF + m * 16; const float r = ROWS ? rms_rstd(ssq, row) : 1.f;
                bf16_t* rowp = O + (size_t)row * ldc + coff + col0;
#pragma unroll
                for (int bj = 0; bj < 2; ++bj) { f32x4 v0 = acc[ai][bj][m][0] * r, v1 = acc[ai][bj][m][1] * r;
                    if (COLS) { v0 = v0 * cv[bj][0]; v1 = v1 * cv[bj][1]; }
                    u32x4 w; w.x = cvt_pk_bf16(v0[0], v0[1]); w.y = cvt_pk_bf16(v0[2], v0[3]); w.z = cvt_pk_bf16(v1[0], v1[1]); w.w = cvt_pk_bf16(v1[2], v1[3]);
                    *(u32x4*)(rowp + bj * HALF) = w; } }
    }
};
struct EpiSwiglu {
    static constexpr bool PERM = true, AFTER_DRAIN = false;
    bf16_t* O; int ldc; const float* ssq;
    __device__ __forceinline__ void operator()(const f32x4 (&acc)[2][2][4][2], const Unit& u, int wr, int wc, int fr, int fq) const {
        const int row0 = u.pm * BM + wr * 64 + fr, col0 = u.pn * HALF + wc * 32 + 8 * fq;
#pragma unroll
        for (int ai = 0; ai < 2; ++ai)
#pragma unroll
            for (int m = 0; m < 4; ++m) { const int row = row0 + ai * HALF + m * 16; const float r = rms_rstd(ssq, row);
                const f32x4 g0 = acc[ai][0][m][0] * r, g1 = acc[ai][0][m][1] * r, u0 = acc[ai][1][m][0] * r, u1 = acc[ai][1][m][1] * r;
                f32x4 a0, a1;
#pragma unroll
                for (int e = 0; e < 4; ++e) { a0[e] = silu_f(g0[e]) * u0[e]; a1[e] = silu_f(g1[e]) * u1[e]; }
                u32x4 w; w.x = cvt_pk_bf16(a0[0], a0[1]); w.y = cvt_pk_bf16(a0[2], a0[3]); w.z = cvt_pk_bf16(a1[0], a1[1]); w.w = cvt_pk_bf16(a1[2], a1[3]);
                *(u32x4*)(O + (size_t)row * ldc + col0) = w; }
    }
};
template <bool OUT_F32, bool OUT_BF16> struct EpiResid {
    static constexpr bool PERM = true, AFTER_DRAIN = false;
    const bf16_t* res; float* out; bf16_t* xb; float* ssq; float alpha;
    __device__ __forceinline__ void operator()(const f32x4 (&acc)[2][2][4][2], const Unit& u, int wr, int wc, int fr, int fq) const {
        const int row0 = u.pm * BM + wr * 64 + fr, col0 = u.pn * BM + wc * 32 + 8 * fq;
#pragma unroll
        for (int ai = 0; ai < 2; ++ai)
#pragma unroll
            for (int m = 0; m < 4; ++m) { const int row = row0 + ai * HALF + m * 16; const size_t off = (size_t)row * 1024 + col0; float s = 0.f;
#pragma unroll
                for (int bj = 0; bj < 2; ++bj) {
                    const u32x4 rb = *(const u32x4*)(res + off + bj * HALF);
                    const f32x4 r0 = (f32x4){__uint_as_float(rb.x << 16), __uint_as_float(rb.x & 0xffff0000u), __uint_as_float(rb.y << 16), __uint_as_float(rb.y & 0xffff0000u)};
                    const f32x4 r1 = (f32x4){__uint_as_float(rb.z << 16), __uint_as_float(rb.z & 0xffff0000u), __uint_as_float(rb.w << 16), __uint_as_float(rb.w & 0xffff0000u)};
                    const f32x4 o0 = r0 + acc[ai][bj][m][0] * alpha, o1 = r1 + acc[ai][bj][m][1] * alpha;
                    if (OUT_F32) { *(f32x4*)(out + off + bj * HALF) = o0; *(f32x4*)(out + off + bj * HALF + 4) = o1; }
                    s += (o0[0] * o0[0] + o0[1] * o0[1]) + (o0[2] * o0[2] + o0[3] * o0[3]) + (o1[0] * o1[0] + o1[1] * o1[1]) + (o1[2] * o1[2] + o1[3] * o1[3]);
                    if (OUT_BF16) { u32x4 w; w.x = cvt_pk_bf16(o0[0], o0[1]); w.y = cvt_pk_bf16(o0[2], o0[3]); w.z = cvt_pk_bf16(o1[0], o1[1]); w.w = cvt_pk_bf16(o1[2], o1[3]);
                        *(u32x4*)(xb + off + bj * HALF) = w; } }
                s += __shfl_xor(s, 16); s += __shfl_xor(s, 32);
                if (fq == 0) (void)__hip_atomic_fetch_add(ssq + row, s, __ATOMIC_RELAXED, __HIP_MEMORY_SCOPE_AGENT);
                asm volatile("" ::: "memory"); }
    }
};

template <class Epi, class Sched, bool ALIGN_EPI = false, bool SP2 = false>
__device__ __forceinline__ void gemm_phase(PG8_LAS unsigned char* lds, const Gemm g, const Sched& S, const Epi& E) {
    const int tid = threadIdx.x, wid = __builtin_amdgcn_readfirstlane(tid >> 6), lane = tid & 63, wr = wid >> 2, wc = wid & 3, fr = lane & 15, fq = lane >> 4;
    const int K = g.K, nt = K / BK;
    unsigned voffA[2], voffB[2];
#pragma unroll
    for (int i = 0; i < 2; ++i) { int R, C; stage_rc(tid * 16 + i * 8192, R, C); const int Rb = Epi::PERM ? ((R & ~31) + perm32(R & 31)) : R;
        voffA[i] = (unsigned)(R * K + C) * 2u; voffB[i] = (unsigned)(Rb * K + C) * 2u; }
    const size_t kstep = (size_t)(BK * 2);
    const size_t hstep = (size_t)HALF * K * 2;
    const size_t tstep = 2 * hstep;
    const unsigned ldsw = (unsigned)wid * 1024u;
    const int aoff = lds_byte(wr * 64 + fr, fq * 8), boff = lds_byte(wc * 32 + fr, fq * 8);
#define PG8_SA(b, h) (((b) * 2 + (h)) * HTB)
#define PG8_SB(b, h) ((4 + (b) * 2 + (h)) * HTB)
#define PG8_STAGE(bufoff, gbase, voff) do { _Pragma("unroll") for (int _i = 0; _i < 2; ++_i) \
        __builtin_amdgcn_global_load_lds((const unsigned*)((const char*)(gbase) + (voff)[_i]), (PG8_LAS unsigned*)(lds + (bufoff) + ldsw + _i * 8192), 16, 0, 0); } while (0)
#define PG8_LDA(dst, b, h) do { _Pragma("unroll") for (int m = 0; m < 4; ++m) _Pragma("unroll") for (int k = 0; k < 2; ++k) dst[m][k] = *(const PG8_LAS bf16x8*)(lds + PG8_SA(b, h) + aoff + m * 2048 + k * 1024); } while (0)
#define PG8_LDB(dst, b, h) do { _Pragma("unroll") for (int n = 0; n < 2; ++n) _Pragma("unroll") for (int k = 0; k < 2; ++k) dst[n][k] = *(const PG8_LAS bf16x8*)(lds + PG8_SB(b, h) + boff + n * 2048 + k * 1024); } while (0)
#define PG8_MMA(ai, bj, At, Bt) do { __builtin_amdgcn_s_setprio(1); _Pragma("unroll") for (int m = 0; m < 4; ++m) _Pragma("unroll") for (int n = 0; n < 2; ++n) _Pragma("unroll") for (int k = 0; k < 2; ++k) \
        acc[ai][bj][m][n] = __builtin_amdgcn_mfma_f32_16x16x32_bf16(Bt[n][k], At[m][k], acc[ai][bj][m][n], 0, 0, 0); __builtin_amdgcn_s_setprio(0); } while (0)
#define PG8_WAIT_V(n) asm volatile("s_waitcnt vmcnt(" #n ")" ::: "memory")
#define PG8_WAIT_L(n) asm volatile("s_waitcnt lgkmcnt(" #n ")" ::: "memory")
#define PG8_BAR __builtin_amdgcn_s_barrier()
#define PG8_SCHED __builtin_amdgcn_sched_barrier(0)
    Unit cur, nxt; int ui = 0;
    if (!S.next(0, cur)) return;
    f32x4 acc[2][2][4][2];
#pragma unroll
    for (int a = 0; a < 2; ++a)
#pragma unroll
        for (int b = 0; b < 2; ++b)
#pragma unroll
            for (int m = 0; m < 4; ++m)
#pragma unroll
                for (int n = 0; n < 2; ++n) acc[a][b][m][n] = (f32x4){0.f, 0.f, 0.f, 0.f};
    bf16x8 At[4][2], B0[2][2], B1[2][2];
    const char* cA = (const char*)g.A + (size_t)cur.pm * tstep; const char* cB = (const char*)g.Bt + (size_t)cur.pn * tstep;
    S.a_ready(cur);
    if constexpr (SP2) {
        PG8_STAGE(PG8_SB(0, 0), cB, voffB); PG8_STAGE(PG8_SB(0, 1), cB + hstep, voffB); PG8_STAGE(PG8_SA(0, 0), cA, voffA); PG8_STAGE(PG8_SA(0, 1), cA + hstep, voffA);
        if (wr == 1) PG8_BAR;
        PG8_WAIT_V(2); PG8_BAR;
        PG8_STAGE(PG8_SB(1, 0), cB + kstep, voffB); PG8_STAGE(PG8_SA(1, 0), cA + kstep, voffA); PG8_STAGE(PG8_SB(1, 1), cB + hstep + kstep, voffB);
        PG8_WAIT_V(6); PG8_BAR;
    } else {
        PG8_STAGE(PG8_SB(0, 0), cB, voffB); PG8_STAGE(PG8_SA(0, 0), cA, voffA); PG8_STAGE(PG8_SB(0, 1), cB + hstep, voffB); PG8_STAGE(PG8_SA(0, 1), cA + hstep, voffA);
        if (wr == 1) PG8_BAR;
        PG8_WAIT_V(4); PG8_BAR;
        PG8_STAGE(PG8_SB(1, 0), cB + kstep, voffB); PG8_STAGE(PG8_SA(1, 0), cA + kstep, voffA); PG8_STAGE(PG8_SB(1, 1), cB + hstep + kstep, voffB);
        PG8_WAIT_V(6); PG8_BAR;
    }
    for (;;) {
        const bool has_next = S.next(ui + 1, nxt);
        const char* nA = has_next ? (const char*)g.A + (size_t)nxt.pm * tstep : cA; const char* nB = has_next ? (const char*)g.Bt + (size_t)nxt.pn * tstep : cB;
        for (int t = 0; t < nt; t += 2) {
            const bool last = (t == nt - 2);
            const char* a1 = cA + (size_t)(t + 1) * kstep;
            const char* a2 = last ? nA : cA + (size_t)(t + 2) * kstep; const char* b2 = last ? nB : cB + (size_t)(t + 2) * kstep;
            const char* a3 = a2 + kstep; const char* b3 = b2 + kstep;
            if (last && has_next) S.a_ready(nxt);
            if constexpr (SP2) {
            PG8_LDB(B0, 0, 0); PG8_LDB(B1, 0, 1); PG8_SCHED; PG8_LDA(At, 0, 0); PG8_STAGE(PG8_SA(1, 1), a1 + hstep, voffA);
            PG8_WAIT_V(8); PG8_WAIT_L(0); PG8_BAR; PG8_MMA(0, 0, At, B0); PG8_MMA(0, 1, At, B1); PG8_BAR; PG8_SCHED;
            PG8_LDA(At, 0, 1); PG8_STAGE(PG8_SB(0, 0), b2, voffB); PG8_STAGE(PG8_SB(0, 1), b2 + hstep, voffB); PG8_STAGE(PG8_SA(0, 0), a2, voffA);
            PG8_WAIT_V(8); PG8_WAIT_L(0); PG8_BAR; PG8_MMA(1, 0, At, B0); PG8_MMA(1, 1, At, B1); PG8_BAR; PG8_SCHED;
            PG8_LDB(B0, 1, 0); PG8_LDB(B1, 1, 1); PG8_SCHED; PG8_LDA(At, 1, 0); PG8_STAGE(PG8_SA(0, 1), a2 + hstep, voffA);
            PG8_WAIT_V(8); PG8_WAIT_L(0); PG8_BAR; PG8_MMA(0, 0, At, B0); PG8_MMA(0, 1, At, B1); PG8_BAR; PG8_SCHED;
            PG8_LDA(At, 1, 1); PG8_STAGE(PG8_SB(1, 0), b3, voffB); PG8_STAGE(PG8_SB(1, 1), b3 + hstep, voffB); PG8_STAGE(PG8_SA(1, 0), a3, voffA);
            PG8_WAIT_V(8); PG8_WAIT_L(0); PG8_BAR; PG8_MMA(1, 0, At, B0); PG8_MMA(1, 1, At, B1); PG8_BAR; PG8_SCHED;
            } else {
            PG8_LDB(B0, 0, 0); PG8_SCHED; PG8_LDA(At, 0, 0); PG8_STAGE(PG8_SA(1, 1), a1 + hstep, voffA);
            PG8_WAIT_L(8); PG8_BAR; PG8_WAIT_L(0); PG8_MMA(0, 0, At, B0); PG8_BAR; PG8_SCHED;
            PG8_LDB(B1, 0, 1); PG8_STAGE(PG8_SB(0, 0), b2, voffB);
            PG8_BAR; PG8_WAIT_L(0); PG8_MMA(0, 1, At, B1); PG8_BAR;
            PG8_LDA(At, 0, 1); PG8_STAGE(PG8_SA(0, 0), a2, voffA);
            PG8_BAR; PG8_WAIT_L(0); PG8_MMA(1, 0, At, B0); PG8_BAR; PG8_SCHED;
            PG8_STAGE(PG8_SB(0, 1), b2 + hstep, voffB);
            PG8_WAIT_V(6); PG8_BAR; PG8_MMA(1, 1, At, B1); PG8_BAR;
            PG8_LDB(B0, 1, 0); PG8_SCHED; PG8_LDA(At, 1, 0); PG8_STAGE(PG8_SA(0, 1), a2 + hstep, voffA);
            PG8_WAIT_L(8); PG8_BAR; PG8_WAIT_L(0); PG8_MMA(0, 0, At, B0); PG8_BAR; PG8_SCHED;
            PG8_LDB(B1, 1, 1); PG8_STAGE(PG8_SB(1, 0), b3, voffB);
            PG8_BAR; PG8_WAIT_L(0); PG8_MMA(0, 1, At, B1); PG8_BAR;
            PG8_LDA(At, 1, 1); PG8_STAGE(PG8_SA(1, 0), a3, voffA);
            PG8_BAR; PG8_WAIT_L(0); PG8_MMA(1, 0, At, B0); PG8_BAR; PG8_SCHED;
            PG8_STAGE(PG8_SB(1, 1), b3 + hstep, voffB);
            PG8_WAIT_V(6); PG8_BAR; PG8_MMA(1, 1, At, B1); PG8_BAR;
            }
        }
        if constexpr (ALIGN_EPI) { if (wr == 0) PG8_BAR; }
        if constexpr (!Epi::AFTER_DRAIN) { E(acc, cur, wr, wc, fr, fq); S.done(cur); }
        if (!has_next) break;
#pragma unroll
        for (int a = 0; a < 2; ++a)
#pragma unroll
            for (int b = 0; b < 2; ++b)
#pragma unroll
                for (int m = 0; m < 4; ++m)
#pragma unroll
                    for (int n = 0; n < 2; ++n) acc[a][b][m][n] = (f32x4){0.f, 0.f, 0.f, 0.f};
        cur = nxt; cA = nA; cB = nB; ++ui;
        if constexpr (ALIGN_EPI) { if (wr == 1) PG8_BAR; }
    }
    PG8_WAIT_V(0);
    if constexpr (!ALIGN_EPI) { if (wr == 0) PG8_BAR; }
    PG8_BAR;
    if constexpr (Epi::AFTER_DRAIN) { E.fused(acc, cur, wr, wc, fr, fq, lds, wid, lane); S.done(cur); }
#undef PG8_SA
#undef PG8_SB
#undef PG8_STAGE
#undef PG8_LDA
#undef PG8_LDB
#undef PG8_MMA
#undef PG8_WAIT_V
#undef PG8_WAIT_L
#undef PG8_BAR
#undef PG8_SCHED
}
}

#ifndef REP_MASK
#define REP_MASK 0
#endif
#ifndef MK_N_LAUNCHES
#define MK_N_LAUNCHES 1
#endif
constexpr int NWAVES = 8;
constexpr int BATCH = 4, SEQ = 4096, D = 1024, FF = 2816, DCONV = 512, DPOOL = 512, NPROJ = 2048;
constexpr int M = BATCH * SEQ;
constexpr int N_PHASES = 10;
constexpr size_t MiB = 1u << 20;
constexpr size_t WS_SSQ = 0, WS_BAR = 512 * 1024;
constexpr size_t WS_WGU1 = 2 * MiB, WS_WD1 = 13 * MiB, WS_WIN = 19 * MiB, WS_WPOOL = 23 * MiB, WS_WOUT = 24 * MiB, WS_WGU2 = 26 * MiB, WS_WD2 = 37 * MiB;
constexpr size_t WS_XB = 44 * MiB;
constexpr size_t WS_H = 76 * MiB;
constexpr size_t WS_PROJ = 76 * MiB, WS_POOLED = 140 * MiB;
constexpr size_t WS_YC = 164 * MiB, WS_END = 196 * MiB;
static_assert(WS_WGU1 + (size_t)2 * FF * D * 2 <= WS_WD1 && WS_WD1 + (size_t)D * FF * 2 <= WS_WIN && WS_WGU2 + (size_t)2 * FF * D * 2 <= WS_WD2 && WS_WD2 + (size_t)D * FF * 2 <= WS_XB, "ws map");
static_assert(WS_H + (size_t)M * FF * 2 <= WS_YC && WS_POOLED + (size_t)M * DPOOL * 2 <= WS_YC && WS_PROJ + (size_t)M * NPROJ * 2 <= WS_POOLED, "ws map");
constexpr int MISC_OFF = 131072 + 1024;
constexpr int LDS_BYTES = 147456;

#define GAS __attribute__((address_space(1)))
#define LAS __attribute__((address_space(3)))
typedef unsigned short bf16;
typedef unsigned v4u __attribute__((ext_vector_type(4)));
typedef unsigned v2u __attribute__((ext_vector_type(2)));
typedef float f32x4 __attribute__((ext_vector_type(4)));
#define LDS_WAIT() asm volatile("s_waitcnt lgkmcnt(0)" ::: "memory")
using pg8::cvt_pk_bf16;

#define XB_TMO      128
#define XB_XCNT(j)  (256  + 64 * (j))
#define XB_XSUB(j)  (1280 + 64 * (j))
#define XB_XGEN(j)  (2304 + 64 * (j))
#define XB_TOP      3328
#define XB_TOPGEN   3392
#define XCD_BAR_WORDS 3456
#define XB_SPIN_CAP (1u << 18)

__device__ __forceinline__ unsigned xb_ld(unsigned* p)              { return __hip_atomic_load(p, __ATOMIC_RELAXED, __HIP_MEMORY_SCOPE_AGENT); }
__device__ __forceinline__ unsigned xb_add(unsigned* p, unsigned v) { return __hip_atomic_fetch_add(p, v, __ATOMIC_RELAXED, __HIP_MEMORY_SCOPE_AGENT); }
__device__ __forceinline__ unsigned xb_xcc_id() { return (unsigned)__builtin_amdgcn_s_getreg((3 << 11) | 20) & 0xFu; }
#define XB_SPIN(cond, bar) do { unsigned _sp = 0; while (cond) { __builtin_amdgcn_s_sleep(1); \
    if ((++_sp & 255u) == 0u) { if (xb_ld(&(bar)[XB_TMO])) break; if (_sp > XB_SPIN_CAP) { atomicAdd(&(bar)[XB_TMO], 1u); break; } } } } while (0)

struct XcdBarrier {
    unsigned* bar; unsigned x;
    volatile LAS unsigned* st;
};

__device__ __forceinline__ XcdBarrier xcd_barrier_post(unsigned* bar, volatile LAS unsigned* st) {
    XcdBarrier b; b.bar = bar; b.x = xb_xcc_id(); b.st = st;
    if (threadIdx.x == 0) (void)xb_add(&bar[XB_XCNT(b.x)], 1u);
    return b;
}
__device__ __forceinline__ void xcd_barrier_complete(unsigned* bar, unsigned x, unsigned& nloc, unsigned& nx) {
    const unsigned G = gridDim.x * gridDim.y * gridDim.z;
    unsigned sum, cnt, mine, sp = 0u;
    for (;;) {
        sum = 0u; cnt = 0u; mine = 0u;
#pragma unroll
        for (unsigned j = 0; j < 16; ++j) { const unsigned c = xb_ld(&bar[XB_XCNT(j)]); sum += c; cnt += (c > 0u) ? 1u : 0u; mine = (j == x) ? c : mine; }
        if (sum == G) break;
        __builtin_amdgcn_s_sleep(1);
        if ((++sp & 255u) == 0u) { if (xb_ld(&bar[XB_TMO])) break; if (sp > XB_SPIN_CAP) { atomicAdd(&bar[XB_TMO], 1u); break; } }
    }
    nloc = mine > 0u ? mine : 1u; nx = cnt > 0u ? cnt : 1u;
}

__device__ __forceinline__ void xcd_barrier(const XcdBarrier& b) {
    asm volatile("s_waitcnt vmcnt(0)" ::: "memory");
    __syncthreads();
    if (threadIdx.x == 0) {
        unsigned* bar = b.bar;
        __builtin_amdgcn_s_waitcnt(0);
        unsigned nloc = b.st[0], nx = b.st[1];
        if (nloc == 0u) { xcd_barrier_complete(bar, b.x, nloc, nx); b.st[0] = nloc; b.st[1] = nx; }
        const unsigned old = xb_add(&bar[XB_XSUB(b.x)], 1u);
        const unsigned gen = old / nloc;
        if (old + 1u == (gen + 1u) * nloc) {
            __builtin_amdgcn_fence(__ATOMIC_RELEASE, "agent");
            asm volatile("s_waitcnt vmcnt(0)" ::: "memory");
            const unsigned og = xb_add(&bar[XB_TOP], 1u);
            const unsigned tg = og / nx;
            if (og + 1u == (tg + 1u) * nx) xb_add(&bar[XB_TOPGEN], 1u);
            else XB_SPIN(xb_ld(&bar[XB_TOPGEN]) == tg, bar);
            __builtin_amdgcn_fence(__ATOMIC_ACQUIRE, "agent");
            xb_add(&bar[XB_XGEN(b.x)], 1u);
            asm volatile("s_waitcnt vmcnt(0)" ::: "memory");
        } else {
            XB_SPIN(xb_ld(&bar[XB_XGEN(b.x)]) == gen, bar);
            __builtin_amdgcn_fence(__ATOMIC_ACQUIRE, "agent");
            asm volatile("s_waitcnt vmcnt(0)" ::: "memory");
        }
    }
    __syncthreads();
}

struct Frame {
    LAS unsigned char* lds;
    int tid, lane, wave, vcu, G;
    const float *x, *g1, *wg1, *wu1, *wd1, *gmix, *win, *convw, *poolw, *pscale, *wout, *g2, *wg2, *wu2, *wd2, *gfin;
    float* out; float *ssq0, *ssq1, *ssq2, *ssq3;
    bf16 *WGU1, *WD1, *WIN, *WPOOL, *WOUT, *WGU2, *WD2, *XB, *H, *PROJ, *POOLED, *YC;
};

__device__ __forceinline__ float wave_sum(float v) {
#pragma unroll
    for (int o = 1; o < 64; o <<= 1) v += __shfl_xor(v, o);
    return v;
}
__device__ __forceinline__ void p0_transpose_item(const float* W, int K, int N, bf16* WT, int mode, const float* gk, LAS float* scr, int item, int lane) {
    const int nblk = N / 32, kb = item / nblk, nb = item % nblk, k0 = 64 * kb, n0 = 32 * nb;
    float wv[32];
#pragma unroll
    for (int i = 0; i < 32; ++i) { const int kk = 2 * i + (lane >> 5); wv[i] = W[(size_t)(k0 + kk) * N + n0 + (lane & 31)]; }
#pragma unroll
    for (int i = 0; i < 32; ++i) { const int kk = 2 * i + (lane >> 5); const float s = gk ? gk[k0 + kk] : 1.f; scr[kk * 33 + (lane & 31)] = wv[i] * s; }
    LDS_WAIT(); asm volatile("" ::: "memory");
    const int c = lane & 7;
    const int d0 = (mode == 0) ? n0 : ((n0 >> 7) * 256 + (n0 & 127) + (mode == 2 ? 128 : 0));
#pragma unroll
    for (int j = 0; j < 4; ++j) { const int n = (lane >> 3) + 8 * j; const LAS float* s = scr + (8 * c) * 33 + n;
        v4u o; o.x = cvt_pk_bf16(s[0 * 33], s[1 * 33]); o.y = cvt_pk_bf16(s[2 * 33], s[3 * 33]); o.z = cvt_pk_bf16(s[4 * 33], s[5 * 33]); o.w = cvt_pk_bf16(s[6 * 33], s[7 * 33]);
        *(GAS v4u*)(WT + (size_t)(d0 + n) * K + k0 + 8 * c) = o; }
    LDS_WAIT(); asm volatile("" ::: "memory");
}
__device__ __forceinline__ void p0_weights(Frame& F, int group, int gw, int NGW, int gt, int NGT) {
    LAS float* scr = (LAS float*)(F.lds + F.wave * 16384);
    constexpr int I_GU = (D / 64) * (FF / 32), I_DN = (FF / 64) * (D / 32), I_IN = (D / 64) * (NPROJ / 32), I_OUT = (D / 64) * (D / 32);
    if (group == 0) {
        for (int it = gw; it < 2 * I_GU; it += NGW) { int r = it;
            if (r < I_GU) { p0_transpose_item(F.wg1, D, FF, F.WGU1, 1, F.g1, scr, r, F.lane); continue; } r -= I_GU;
            p0_transpose_item(F.wu1, D, FF, F.WGU1, 2, F.g1, scr, r, F.lane); }
    } else if (group == 1) {
        for (int it = gw; it < I_DN + I_IN + I_OUT + 2 * I_GU; it += NGW) { int r = it;
            if (r < I_DN) { p0_transpose_item(F.wd1, FF, D, F.WD1, 0, nullptr, scr, r, F.lane); continue; } r -= I_DN;
            if (r < I_IN) { p0_transpose_item(F.win, D, NPROJ, F.WIN, 0, F.gmix, scr, r, F.lane); continue; } r -= I_IN;
            if (r < I_OUT) { p0_transpose_item(F.wout, D, D, F.WOUT, 0, nullptr, scr, r, F.lane); continue; } r -= I_OUT;
            if (r < I_GU) { p0_transpose_item(F.wg2, D, FF, F.WGU2, 1, F.g2, scr, r, F.lane); continue; } r -= I_GU;
            p0_transpose_item(F.wu2, D, FF, F.WGU2, 2, F.g2, scr, r, F.lane); }
        for (int idx = gt; idx < DPOOL * DPOOL; idx += NGT) { const int n = idx >> 9, k = idx & 511; const int gn = n >> 7, gk = k >> 7;
            const float v = (gn == gk) ? F.poolw[(size_t)gn * 16384 + (k & 127) * 128 + (n & 127)] : 0.f;
            F.WPOOL[idx] = (bf16)(cvt_pk_bf16(v, 0.f) & 0xffffu); }
    } else {
        for (int it = gw; it < I_DN; it += NGW) p0_transpose_item(F.wd2, FF, D, F.WD2, 0, nullptr, scr, it, F.lane);
    }
}
__device__ __forceinline__ void tail_weights(Frame& F, int group, int nwg) {
    const int rem = nwg % F.G, first = rem, nworkers = F.G - first, bx = (int)blockIdx.x;
    if (bx >= first) p0_weights(F, group, (bx - first) * NWAVES + F.wave, nworkers * NWAVES, (bx - first) * NWAVES * 64 + F.tid, nworkers * NWAVES * 64);
}
__device__ __forceinline__ void p0_prologue(Frame& F) {
    const int gw = F.vcu * NWAVES + F.wave, NGW = F.G * NWAVES;
    const int gt = F.vcu * (NWAVES * 64) + F.tid, NGT = F.G * NWAVES * 64;
    p0_weights(F, 0, gw, NGW, gt, NGT);
    for (int idx = gt; idx < 3 * M; idx += NGT) F.ssq1[idx] = 0.f;
    for (int m = gw; m < M; m += NGW) {
        const GAS f32x4* xr = (const GAS f32x4*)(F.x + (size_t)m * D) + F.lane;
        f32x4 v[4]; float s = 0.f;
#pragma unroll
        for (int j = 0; j < 4; ++j) { v[j] = xr[64 * j]; s += (v[j].x * v[j].x + v[j].y * v[j].y) + (v[j].z * v[j].z + v[j].w * v[j].w); }
        s = wave_sum(s);
        if (F.lane == 0) F.ssq0[m] = s;
        GAS v2u* o8 = (GAS v2u*)(F.XB + (size_t)m * D) + F.lane;
#pragma unroll
        for (int j = 0; j < 4; ++j) { v2u o; o.x = cvt_pk_bf16(v[j].x, v[j].y); o.y = cvt_pk_bf16(v[j].z, v[j].w); o8[64 * j] = o; }
    }
}
__device__ __forceinline__ void unpack8(const v4u q, float (&f)[8]) {
    f[0] = __uint_as_float(q.x << 16); f[1] = __uint_as_float(q.x & 0xffff0000u); f[2] = __uint_as_float(q.y << 16); f[3] = __uint_as_float(q.y & 0xffff0000u);
    f[4] = __uint_as_float(q.z << 16); f[5] = __uint_as_float(q.z & 0xffff0000u); f[6] = __uint_as_float(q.w << 16); f[7] = __uint_as_float(q.w & 0xffff0000u);
}
__device__ __forceinline__ v4u pack8(const float (&f)[8]) { v4u o; o.x = cvt_pk_bf16(f[0], f[1]); o.y = cvt_pk_bf16(f[2], f[3]); o.z = cvt_pk_bf16(f[4], f[5]); o.w = cvt_pk_bf16(f[6], f[7]); return o; }
__device__ __forceinline__ void mix_phase(Frame& F) {
    const int lane = F.lane, c8 = lane * 8, w = 2 << (lane >> 4);
    float w0[8], w1[8], w2[8];
#pragma unroll
    for (int e = 0; e < 8; ++e) { w0[e] = F.convw[c8 + e]; w1[e] = F.convw[DCONV + c8 + e]; w2[e] = F.convw[2 * DCONV + c8 + e]; }
    const int gw = F.vcu * NWAVES + F.wave, NGW = F.G * NWAVES;
    for (int item = gw; item < M / 8; item += NGW) {
        const int t0 = item * 8, p0 = t0 & (SEQ - 1);
        const bf16* prow = F.PROJ + (size_t)t0 * NPROJ + c8;
        float z1[8], z2[8];
#pragma unroll
        for (int e = 0; e < 8; ++e) { z1[e] = 0.f; z2[e] = 0.f; }
        if (p0 > 0) { float a[8], b[8];
            unpack8(*(const GAS v4u*)(prow - 2 * NPROJ), a); unpack8(*(const GAS v4u*)(prow - 2 * NPROJ + 1024), b);
#pragma unroll
            for (int e = 0; e < 8; ++e) z2[e] = a[e] * b[e];
            unpack8(*(const GAS v4u*)(prow - NPROJ), a); unpack8(*(const GAS v4u*)(prow - NPROJ + 1024), b);
#pragma unroll
            for (int e = 0; e < 8; ++e) z1[e] = a[e] * b[e]; }
#pragma unroll
        for (int j = 0; j < 8; ++j) { float a[8], b[8], c[8], y[8];
            unpack8(*(const GAS v4u*)(prow + j * NPROJ), a); unpack8(*(const GAS v4u*)(prow + j * NPROJ + 512), b); unpack8(*(const GAS v4u*)(prow + j * NPROJ + 1024), c);
#pragma unroll
            for (int e = 0; e < 8; ++e) { const float z0 = c[e] * a[e]; y[e] = b[e] * (w0[e] * z2[e] + w1[e] * z1[e] + w2[e] * z0); z2[e] = z1[e]; z1[e] = z0; }
            *(GAS v4u*)(F.YC + (size_t)(t0 + j) * D + c8) = pack8(y); }
        const bf16* urow = prow + 1536;
        float S[8];
#pragma unroll
        for (int e = 0; e < 8; ++e) S[e] = 0.f;
#pragma unroll
        for (int i = 15; i >= 1; --i) if (i < w && p0 - i >= 0) { float a[8]; unpack8(*(const GAS v4u*)(urow - i * NPROJ), a);
#pragma unroll
            for (int e = 0; e < 8; ++e) S[e] += a[e]; }
#pragma unroll
        for (int j = 0; j < 8; ++j) { float a[8], y[8]; unpack8(*(const GAS v4u*)(urow + j * NPROJ), a);
            const int cnt = (p0 + j + 1) < w ? (p0 + j + 1) : w; const float inv = 1.0f / (float)cnt;
#pragma unroll
            for (int e = 0; e < 8; ++e) { S[e] += a[e]; y[e] = S[e] * inv - a[e]; }
            *(GAS v4u*)(F.POOLED + (size_t)(t0 + j) * DPOOL + c8) = pack8(y);
            const int idx = j - (w - 1);
            if (p0 + idx >= 0) { float o[8]; unpack8(*(const GAS v4u*)(urow + idx * NPROJ), o);
#pragma unroll
                for (int e = 0; e < 8; ++e) S[e] -= o[e]; } }
    }
}
__device__ __forceinline__ void final_norm(Frame& F) {
    const int gw = F.vcu * NWAVES + F.wave, NGW = F.G * NWAVES;
    f32x4 gf[4];
#pragma unroll
    for (int j = 0; j < 4; ++j) gf[j] = ((const GAS f32x4*)F.gfin)[64 * j + F.lane];
    for (int m = gw; m < M; m += NGW) { const float r = pg8::rms_rstd(F.ssq3, m);
        GAS f32x4* xr = (GAS f32x4*)(F.out + (size_t)m * D) + F.lane;
#pragma unroll
        for (int j = 0; j < 4; ++j) { const f32x4 v = xr[64 * j]; xr[64 * j] = v * r * gf[j]; } }
}

struct Args { const float* in[16]; float* out; unsigned char* ws; int ph_lo, ph_hi; };
__global__ void __launch_bounds__(NWAVES * 64, 2) fwd_kernel(Args args) {
    extern __shared__ __attribute__((aligned(16))) unsigned char lds[];
    cg::grid_group grid = cg::this_grid();
    Frame F;
    F.lds = (LAS unsigned char*)lds;
    F.tid = threadIdx.x; F.lane = F.tid & 63; F.wave = __builtin_amdgcn_readfirstlane(F.tid >> 6);
    F.G = gridDim.x; { const int bx = blockIdx.x; F.vcu = (F.G % 8 == 0) ? (bx % 8) * (F.G / 8) + bx / 8 : bx; }
    unsigned char* ws = args.ws;
    F.x = args.in[0]; F.g1 = args.in[1]; F.wg1 = args.in[2]; F.wu1 = args.in[3]; F.wd1 = args.in[4]; F.gmix = args.in[5]; F.win = args.in[6]; F.convw = args.in[7];
    F.poolw = args.in[8]; F.pscale = args.in[9]; F.wout = args.in[10]; F.g2 = args.in[11]; F.wg2 = args.in[12]; F.wu2 = args.in[13]; F.wd2 = args.in[14]; F.gfin = args.in[15];
    F.out = args.out;
    F.ssq0 = (float*)(ws + WS_SSQ); F.ssq1 = F.ssq0 + M; F.ssq2 = F.ssq1 + M; F.ssq3 = F.ssq2 + M;
    F.WGU1 = (bf16*)(ws + WS_WGU1); F.WD1 = (bf16*)(ws + WS_WD1); F.WIN = (bf16*)(ws + WS_WIN); F.WPOOL = (bf16*)(ws + WS_WPOOL); F.WOUT = (bf16*)(ws + WS_WOUT);
    F.WGU2 = (bf16*)(ws + WS_WGU2); F.WD2 = (bf16*)(ws + WS_WD2); F.XB = (bf16*)(ws + WS_XB); F.H = (bf16*)(ws + WS_H); F.PROJ = (bf16*)(ws + WS_PROJ);
    F.POOLED = (bf16*)(ws + WS_POOLED); F.YC = (bf16*)(ws + WS_YC);
    const int lo = args.ph_lo, hi = args.ph_hi;
    volatile LAS unsigned* MISC = (volatile LAS unsigned*)(F.lds + MISC_OFF);
    if (F.tid < 32) MISC[F.tid] = 0u;
    __syncthreads();
    unsigned* barw = (unsigned*)(ws + WS_BAR);
    XcdBarrier bar; bar.bar = barw; bar.x = 0; bar.st = nullptr;
#define IN(k) (lo <= (k) && (k) < hi)
#define PHASE(k, ...) if (IN(k)) { { __VA_ARGS__; } if constexpr (((REP_MASK >> (k)) & 1) != 0) { xcd_barrier(bar); { __VA_ARGS__; } } }
#define SEAM(k) do { if (IN(k) && IN((k) + 1)) xcd_barrier(bar); } while (0)
    const int bx = (int)blockIdx.x;
    if (hi > lo + 1) bar = xcd_barrier_post(barw, MISC + 8);
    if (lo < 0) grid.sync();
    PHASE(0, p0_prologue(F);)
    SEAM(0);
    PHASE(1, pg8::Gemm g{F.XB, F.WGU1, M, 2 * FF, D}; pg8::StaticOrder S; S.init(M, 2 * FF, F.G, bx);
        pg8::EpiSwiglu E{F.H, FF, F.ssq0};
        pg8::gemm_phase<pg8::EpiSwiglu, pg8::StaticOrder, true, true>(F.lds, g, S, E); tail_weights(F, 1, (M / 256) * (2 * FF / 256));)
    SEAM(1);
    PHASE(2, pg8::Gemm g{F.H, F.WD1, M, D, FF}; pg8::StaticOrder S; S.init(M, D, F.G, bx);
        pg8::EpiResid<false, true> E{F.XB, nullptr, F.XB, F.ssq1, 0.5f};
        pg8::gemm_phase<pg8::EpiResid<false, true>, pg8::StaticOrder, true, true>(F.lds, g, S, E);)
    SEAM(2);
    PHASE(3, pg8::Gemm g{F.XB, F.WIN, M, NPROJ, D}; pg8::StaticOrder S; S.init(M, NPROJ, F.G, bx);
        pg8::EpiScaleBf16<true, false> E{F.PROJ, NPROJ, 0, F.ssq1, nullptr};
        pg8::gemm_phase<pg8::EpiScaleBf16<true, false>, pg8::StaticOrder, true, true>(F.lds, g, S, E);)
    SEAM(3);
    PHASE(4, mix_phase(F);)
    SEAM(4);
    PHASE(5, pg8::Gemm g{F.POOLED, F.WPOOL, M, DPOOL, DPOOL}; pg8::StaticOrder S; S.init(M, DPOOL, F.G, bx);
        pg8::EpiScaleBf16<false, true> E{F.YC, D, DCONV, nullptr, F.pscale};
        pg8::gemm_phase<pg8::EpiScaleBf16<false, true>, pg8::StaticOrder, true, true>(F.lds, g, S, E);)
    SEAM(5);
    PHASE(6, pg8::Gemm g{F.YC, F.WOUT, M, D, D}; pg8::StaticOrder S; S.init(M, D, F.G, bx);
        pg8::EpiResid<false, true> E{F.XB, nullptr, F.XB, F.ssq2, 1.0f};
        pg8::gemm_phase<pg8::EpiResid<false, true>, pg8::StaticOrder, true, true>(F.lds, g, S, E);)
    SEAM(6);
    PHASE(7, pg8::Gemm g{F.XB, F.WGU2, M, 2 * FF, D}; pg8::StaticOrder S; S.init(M, 2 * FF, F.G, bx);
        pg8::EpiSwiglu E{F.H, FF, F.ssq2};
        pg8::gemm_phase<pg8::EpiSwiglu, pg8::StaticOrder, true, true>(F.lds, g, S, E); tail_weights(F, 2, (M / 256) * (2 * FF / 256));)
    SEAM(7);
    PHASE(8, pg8::Gemm g{F.H, F.WD2, M, D, FF}; pg8::StaticOrder S; S.init(M, D, F.G, bx);
        pg8::EpiResid<true, false> E{F.XB, F.out, nullptr, F.ssq3, 0.5f};
        pg8::gemm_phase<pg8::EpiResid<true, false>, pg8::StaticOrder, true, true>(F.lds, g, S, E);)
    SEAM(8);
    if (IN(9)) { final_norm(F); }
#undef IN
#undef SEAM
}

extern "C" void kernel_launch(void* const* d_in, const int* in_sizes, int n_in, void* d_out, int out_size, void* d_ws, size_t ws_size, hipStream_t stream) {
    static int grid = 0;
    if (grid == 0) {
        if (n_in != 16 || in_sizes[0] != M * D || out_size != M * D || ws_size < WS_END) { fprintf(stderr, "kernel_launch: unexpected shapes (n_in %d, in0 %d, out %d, ws %zu)\n", n_in, n_in > 0 ? in_sizes[0] : -1, out_size, ws_size); grid = -1; return; }
        int dev = 0, cus = 0, per_cu = 0;
        if (hipGetDevice(&dev) != hipSuccess || hipDeviceGetAttribute(&cus, hipDeviceAttributeMultiprocessorCount, dev) != hipSuccess) { grid = -1; return; }
        if (hipFuncSetAttribute((const void*)fwd_kernel, hipFuncAttributeMaxDynamicSharedMemorySize, LDS_BYTES) != hipSuccess) { fprintf(stderr, "kernel_launch: hipFuncSetAttribute failed\n"); grid = -1; return; }
        if (hipOccupancyMaxActiveBlocksPerMultiprocessor(&per_cu, (const void*)fwd_kernel, NWAVES * 64, LDS_BYTES) != hipSuccess || per_cu < 1) { fprintf(stderr, "kernel_launch: occupancy query says %d\n", per_cu); per_cu = 1; }
        (void)hipGetLastError();
        grid = cus * per_cu;
    }
    if (grid < 0) return;
    if (hipMemsetAsync((char*)d_ws + WS_BAR, 0, XCD_BAR_WORDS * 4, stream) != hipSuccess) { fprintf(stderr, "kernel_launch: memset failed\n"); return; }
    Args a{};
    for (int i = 0; i < 16; ++i) a.in[i] = (const float*)d_in[i];
    a.out = (float*)d_out; a.ws = (unsigned char*)d_ws;
#if MK_N_LAUNCHES == 1
    a.ph_lo = 0; a.ph_hi = N_PHASES;
    void* kargs[] = {&a};
    hipError_t e = hipLaunchCooperativeKernel((const void*)fwd_kernel, dim3(grid), dim3(NWAVES * 64), kargs, LDS_BYTES, stream);
    if (e != hipSuccess) fprintf(stderr, "cooperative launch failed: %s (grid %d)\n", hipGetErrorString(e), grid);
#else
    for (int p = 0; p < N_PHASES; ++p) { a.ph_lo = p; a.ph_hi = p + 1;
        hipLaunchKernelGGL(fwd_kernel, dim3(grid), dim3(NWAVES * 64), LDS_BYTES, stream, a); }
#endif
}
```
